# Optimizing an MI355X kernel written in HIP

```python
import jax, jax.numpy as jnp
from jax import lax
import numpy as np

D_MODEL = 2048
BATCH = 4
SEQ = 2048
DEPTH = 1
DEC_BATCH = 128
DEC_SEQ = 4
PAST_LEN = 16384
PAGE_SIZE = 128

N_META = 16
MIX_WIDTH = D_MODEL
RWKV_WIDTH = MIX_WIDTH // 2
RWKV_HEAD = 64
RWKV_HEADS = RWKV_WIDTH // RWKV_HEAD
DECAY_LORA = 64
AAA_LORA = 64
GATE_LORA = 160
RWKV_COLS = 3 * RWKV_WIDTH + DECAY_LORA + AAA_LORA + GATE_LORA
RET_WIDTH = MIX_WIDTH - RWKV_WIDTH
RET_HEADS = 4
RET_HEAD = RET_WIDTH // RET_HEADS
RET_COLS = 4 * RET_WIDTH
IN_COLS = RWKV_COLS + RET_COLS
RET_CHUNK = 128
D_FF = -(-8 * D_MODEL // (3 * 256)) * 256
RMS_EPS = 1e-6
RWKV_GN_EPS = 64e-5
RET_GN_EPS = 1e-6
ROPE_BASE = 10000.0

kernel_name = 'hybrid_rwkv7_retention_decode_step'

F32 = jnp.float32


def rms_norm(x, g):
    xf = x.astype(F32)
    y = xf * lax.rsqrt(jnp.mean(xf * xf, axis=-1, keepdims=True) + RMS_EPS)
    return (y * g.astype(F32)).astype(x.dtype)


def rwkv7_scan(r, w, k, v, a_vec, b_vec, S0):
    def step(S, inp):
        r_t, w_t, k_t, v_t, a_t, b_t = inp
        sa = jnp.einsum('bhij,bhj->bhi', S, a_t)
        S = S * w_t[:, :, None, :] + sa[..., None] * b_t[:, :, None, :] + v_t[..., None] * k_t[:, :, None, :]
        return S, jnp.einsum('bhij,bhj->bhi', S, r_t)
    xs = tuple(jnp.swapaxes(t, 0, 1) for t in (r, w, k, v, a_vec, b_vec))
    S, out = lax.scan(step, S0, xs)
    return jnp.swapaxes(out, 0, 1), S


def rwkv7_mixer(z, z_prev, S0, mu, w0, w2, a0, a2, g2, k_k, k_a, r_k, ln_w, ln_b):
    B, T, _ = z.shape
    W = RWKV_WIDTH
    zs = z + mu * (z_prev - z)
    r, k, v, wd, ad, gd = jnp.split(zs, [W, 2 * W, 3 * W, 3 * W + DECAY_LORA, 3 * W + DECAY_LORA + AAA_LORA], axis=-1)
    heads = lambda t: t.reshape(B, T, RWKV_HEADS, RWKV_HEAD)
    w = -jax.nn.softplus(-(w0 + jnp.tanh(wd) @ w2)) - 0.5
    decay = jnp.exp(-jnp.exp(w))
    a = jax.nn.sigmoid(a0 + ad @ a2)
    g = jax.nn.sigmoid(gd) @ g2
    kk = heads(k * k_k)
    kk = kk / jnp.maximum(jnp.sqrt(jnp.sum(kk * kk, axis=-1, keepdims=True)), 1e-12)
    k = k * (1.0 + (a - 1.0) * k_a)
    rh, kh, vh = heads(r), heads(k), heads(v)
    o, S = rwkv7_scan(rh, heads(decay), kh, vh, -kk, kk * heads(a), S0)
    mean = jnp.mean(o, axis=-1, keepdims=True)
    var = jnp.mean(jnp.square(o - mean), axis=-1, keepdims=True)
    o = ((o - mean) * lax.rsqrt(var + RWKV_GN_EPS)).reshape(B, T, W) * ln_w + ln_b
    bonus = jnp.sum(rh * kh * r_k, axis=-1, keepdims=True) * vh
    o = o + bonus.reshape(B, T, W)
    return o * g, S


def rotary(x, pos):
    inv_freq = 1.0 / (ROPE_BASE ** jnp.linspace(0.0, 1.0, RET_HEAD // 2, dtype=F32))
    ang = pos.astype(F32)[:, None] * inv_freq[None, :]
    cos = jnp.cos(ang)[None, :, None, :]
    sin = jnp.sin(ang)[None, :, None, :]
    x0 = x[..., 0::2]
    x1 = x[..., 1::2]
    return jnp.stack([x0 * cos - x1 * sin, x0 * sin + x1 * cos], axis=-1).reshape(x.shape)


def retention_chunk(q, k, v, S, log_gamma):
    C = q.shape[1]
    idx = jnp.arange(C, dtype=F32)
    diff = idx[:, None] - idx[None, :]
    dmask = jnp.where(diff[None] >= 0, jnp.exp(log_gamma[:, None, None] * jnp.maximum(diff, 0.0)[None]), 0.0)
    scores = jnp.einsum('bihd,bjhd->bhij', q, k) * dmask[None]
    o_intra = jnp.einsum('bhij,bjhe->bihe', scores, v)
    inter_scale = jnp.exp(log_gamma[None, :] * (idx + 1.0)[:, None])
    o_inter = jnp.einsum('bihd,bhde->bihe', q, S) * inter_scale[None, :, :, None]
    k_scale = jnp.exp(log_gamma[:, None] * (C - 1.0 - idx)[None, :])
    S_new = jnp.exp(log_gamma * C)[None, :, None, None] * S + jnp.einsum('bjhd,hj,bjhe->bhde', k, k_scale, v)
    return o_intra + o_inter, S_new


def retention_mixer(z, S0, pos, prompt):
    B, T, _ = z.shape
    q, k, v, g = jnp.split(z, 4, axis=-1)
    heads = lambda t: t.reshape(B, T, RET_HEADS, RET_HEAD)
    q = rotary(heads(q), pos)
    k = rotary(heads(k), pos) * (RET_HEAD ** -0.5)
    v = heads(v)
    log_gamma = jnp.log(1.0 - 2.0 ** (-5.0 - jnp.arange(RET_HEADS, dtype=F32)))
    if prompt:
        o_m, S = retention_chunk(q[:, :N_META], k[:, :N_META], v[:, :N_META], S0, log_gamma)
        n_chunks = (T - N_META) // RET_CHUNK
        to_chunks = lambda t: jnp.swapaxes(t[:, N_META:].reshape(B, n_chunks, RET_CHUNK, RET_HEADS, RET_HEAD), 0, 1)

        def body(S_c, qkv):
            o_c, S_c = retention_chunk(qkv[0], qkv[1], qkv[2], S_c, log_gamma)
            return S_c, o_c

        S, o_c = lax.scan(body, S, (to_chunks(q), to_chunks(k), to_chunks(v)))
        o = jnp.concatenate([o_m, jnp.swapaxes(o_c, 0, 1).reshape(B, T - N_META, RET_HEADS, RET_HEAD)], axis=1)
    else:
        o, S = retention_chunk(q, k, v, S0, log_gamma)
    o = o * lax.rsqrt(jnp.mean(o * o, axis=-1, keepdims=True) + RET_GN_EPS)
    return o.reshape(B, T, RET_WIDTH) * jax.nn.silu(g), S


def decoder_layer(x, shift0, S_a0, S_b0, pos, prompt, norm_mix, w_in, rwkv_mu, rwkv_w0, rwkv_w2,
                  rwkv_a0, rwkv_a2, rwkv_g2, rwkv_kk, rwkv_ka, rwkv_rk, rwkv_ln_w, rwkv_ln_b,
                  w_out, norm_ffn, w_gate, w_up, w_down):
    f = lambda t: t.astype(F32)
    xn = f(rms_norm(x, norm_mix))
    z = xn @ f(w_in)
    z_a, z_b = z[..., :RWKV_COLS], z[..., RWKV_COLS:]
    z_prev = jnp.concatenate([f(shift0)[:, None], z_a[:, :-1]], axis=1)
    o_a, S_a = rwkv7_mixer(z_a, z_prev, f(S_a0), f(rwkv_mu), f(rwkv_w0), f(rwkv_w2), f(rwkv_a0),
                           f(rwkv_a2), f(rwkv_g2), f(rwkv_kk), f(rwkv_ka), f(rwkv_rk),
                           f(rwkv_ln_w), f(rwkv_ln_b))
    o_b, S_b = retention_mixer(z_b, f(S_b0), pos, prompt)
    h = x + (jnp.concatenate([o_a, o_b], axis=-1) @ f(w_out)).astype(x.dtype)
    hn = rms_norm(h, norm_ffn)
    h = h + (jax.nn.silu(hn @ w_gate) * (hn @ w_up)) @ w_down
    return h, z_a[:, -1], S_a, S_b


def setup_inputs(seed: int = 0) -> dict:
    key = jax.random.key(seed)
    ks = jax.random.split(key, 32)
    n = lambda i, shape: jax.random.normal(ks[i], shape, F32)
    L = DEPTH
    return {
        'x_prompt': n(0, (BATCH, SEQ, D_MODEL)),
        'x_sample': n(1, (DEC_BATCH, DEC_SEQ, D_MODEL)),
        'state_shift': n(2, (L, DEC_BATCH, RWKV_COLS)),
        'state_rwkv': n(3, (L, DEC_BATCH, RWKV_HEADS, RWKV_HEAD, RWKV_HEAD)),
        'state_ret': 0.5 * n(4, (L, DEC_BATCH, RET_HEADS, RET_HEAD, RET_HEAD)),
        'meta_tokens': n(5, (N_META, D_MODEL)),
        'norm_mix': 1.0 + 0.05 * n(6, (L, D_MODEL)),
        'w_in': n(7, (L, D_MODEL, IN_COLS)) * D_MODEL ** -0.5,
        'rwkv_mu': jax.random.uniform(ks[8], (L, RWKV_COLS), F32),
        'rwkv_w0': jax.random.uniform(ks[9], (L, RWKV_WIDTH), F32, -6.0, -1.0),
        'rwkv_w2': n(10, (L, DECAY_LORA, RWKV_WIDTH)) * 0.1 * DECAY_LORA ** -0.5,
        'rwkv_a0': 0.1 * n(11, (L, RWKV_WIDTH)),
        'rwkv_a2': n(12, (L, AAA_LORA, RWKV_WIDTH)) * 0.5 * AAA_LORA ** -0.5,
        'rwkv_g2': n(13, (L, GATE_LORA, RWKV_WIDTH)) * GATE_LORA ** -0.5,
        'rwkv_kk': 0.85 + 0.05 * n(14, (L, RWKV_WIDTH)),
        'rwkv_ka': 1.0 + 0.05 * n(15, (L, RWKV_WIDTH)),
        'rwkv_rk': 0.1 * n(16, (L, RWKV_HEADS, RWKV_HEAD)),
        'rwkv_ln_w': 1.0 + 0.05 * n(17, (L, RWKV_WIDTH)),
        'rwkv_ln_b': 0.02 * n(18, (L, RWKV_WIDTH)),
        'w_out': n(19, (L, MIX_WIDTH, D_MODEL)) * 0.5 * MIX_WIDTH ** -0.5,
        'norm_ffn': 1.0 + 0.05 * n(20, (L, D_MODEL)),
        'w_gate': n(21, (L, D_MODEL, D_FF)) * D_MODEL ** -0.5,
        'w_up': n(22, (L, D_MODEL, D_FF)) * D_MODEL ** -0.5,
        'w_down': n(23, (L, D_FF, D_MODEL)) * D_FF ** -0.5,
        'norm_final': 1.0 + 0.05 * n(24, (D_MODEL,)),
    }


def reference(x_prompt, x_sample, state_shift, state_rwkv, state_ret, meta_tokens, norm_mix, w_in,
              rwkv_mu, rwkv_w0, rwkv_w2, rwkv_a0, rwkv_a2, rwkv_g2, rwkv_kk, rwkv_ka, rwkv_rk,
              rwkv_ln_w, rwkv_ln_b, w_out, norm_ffn, w_gate, w_up, w_down, norm_final):
    B_p = x_prompt.shape[0]
    meta = jnp.broadcast_to(meta_tokens[None].astype(x_prompt.dtype), (B_p, N_META, x_prompt.shape[-1]))
    h_p = jnp.concatenate([meta, x_prompt], axis=1)
    h_s = x_sample
    pos_p = jnp.arange(h_p.shape[1])
    pos_s = PAST_LEN + jnp.arange(x_sample.shape[1])
    shift0_p = jnp.zeros((B_p, RWKV_COLS), F32)
    rwkv0_p = jnp.zeros((B_p, RWKV_HEADS, RWKV_HEAD, RWKV_HEAD), F32)
    ret0_p = jnp.zeros((B_p, RET_HEADS, RET_HEAD, RET_HEAD), F32)
    sh_p, ra_p, rb_p, sh_s, ra_s, rb_s = [], [], [], [], [], []
    for l in range(DEPTH):
        lw = (norm_mix[l], w_in[l], rwkv_mu[l], rwkv_w0[l], rwkv_w2[l], rwkv_a0[l], rwkv_a2[l],
              rwkv_g2[l], rwkv_kk[l], rwkv_ka[l], rwkv_rk[l], rwkv_ln_w[l], rwkv_ln_b[l],
              w_out[l], norm_ffn[l], w_gate[l], w_up[l], w_down[l])
        h_p, s1, s2, s3 = decoder_layer(h_p, shift0_p, rwkv0_p, ret0_p, pos_p, True, *lw)
        sh_p.append(s1); ra_p.append(s2); rb_p.append(s3)
        h_s, s1, s2, s3 = decoder_layer(h_s, state_shift[l], state_rwkv[l], state_ret[l], pos_s, False, *lw)
        sh_s.append(s1); ra_s.append(s2); rb_s.append(s3)
    y_prompt = rms_norm(h_p, norm_final)[:, N_META:]
    y_sample = rms_norm(h_s, norm_final)
    return (y_prompt, y_sample, jnp.stack(sh_p), jnp.stack(ra_p), jnp.stack(rb_p),
            jnp.stack(sh_s), jnp.stack(ra_s), jnp.stack(rb_s))
```

```cpp
#define MK_MULTI 0
#include <hip/hip_runtime.h>
#include <hip/hip_cooperative_groups.h>
#include <cstdio>
#include <cstdint>
namespace cg = cooperative_groups;
namespace pg8 {
#define PG8_LAS __attribute__((address_space(3)))
typedef unsigned short bf16_t;
typedef short bf16x8 __attribute__((ext_vector_type(8)));
typedef float f32x4 __attribute__((ext_vector_type(4)));
typedef unsigned u32x4 __attribute__((ext_vector_type(4)));
constexpr int BM = 256, BK = 64, HALF = 128, HTB = HALF * BK * 2  , STAGE_BYTES = 8 * HTB, NXCD = 8, WGM = 4;

__host__ __device__ __forceinline__ int lds_byte(int r, int c) { const int st = (r >> 4) * 2 + (c >> 5), rr = r & 15, cc = c & 31, ob = rr * 64 + cc * 2; return st * 1024 + (ob ^ (((ob >> 9) & 1) << 5)); }
__host__ __device__ __forceinline__ void stage_rc(int b, int& R, int& C) { const int st = b / 1024, sb = b % 1024, swz = sb ^ (((sb >> 9) & 1) << 5); R = (st >> 1) * 16 + swz / 64; C = (st & 1) * 32 + (swz % 64) / 2; }
__host__ __device__ __forceinline__ int perm32(int rho) { const int n = rho >> 4, i = rho & 15; return 8 * (i >> 2) + 4 * n + (i & 3); }

struct Unit { int pm, pn, ks, aux; };
struct Gemm { const bf16_t* A; const bf16_t* Bt; int M, N, K, ld; };

struct StaticOrder {
    int nM, nN, nwg, G, c, limit;
    __host__ __device__ void init(int M, int N, int G_, int c_) { nM = M / BM; nN = N / BM; nwg = nM * nN; G = G_; c = c_; limit = nwg; }
    __host__ __device__ __forceinline__ bool next(int i, Unit& u) const {
        const long L = (long)i * G + c; if (L >= limit) return false;
        return map((int)L, u);
    }
    __host__ __device__ __forceinline__ bool map(int L, Unit& u) const {
        int wgid = L; u.ks = 0; u.aux = 0; { const int q = nwg / NXCD, r = nwg % NXCD, xcd = wgid % NXCD, off = wgid / NXCD; wgid = (xcd < r ? xcd * (q + 1) : r * (q + 1) + (xcd - r) * q) + off; }
        const int nig = WGM * nN, gid = wgid / nig, fm = gid * WGM, gsz = (nM - fm) < WGM ? (nM - fm) : WGM;
        u.pm = fm + ((wgid % nig) % gsz); u.pn = (wgid % nig) / gsz; return true;
    }
    __device__ __forceinline__ void a_ready(const Unit&) const {}
    __device__ __forceinline__ void done(const Unit&) const {}
};


__device__ __forceinline__ unsigned cvt_pk_bf16(float lo, float hi) { unsigned r; asm volatile("v_cvt_pk_bf16_f32 %0, %1, %2" : "=v"(r) : "v"(lo), "v"(hi)); return r; }

constexpr int E_MP = 8256, E_MR = 8768, E_TP = 2064, E_RC = 3360;

#define EPI_WALK() \
    __device__ __forceinline__ void operator()(const f32x4 (&acc)[2][2][4][2], const Unit& u, int wr, int wc, int fr, int fq) const { \
        _Pragma("unroll") for (int ai = 0; ai < 2; ++ai) _Pragma("unroll") for (int m = 0; m < 4; ++m) { \
            f32x4 a[2][2]; a[0][0] = acc[ai][0][m][0]; a[0][1] = acc[ai][0][m][1]; a[1][0] = acc[ai][1][m][0]; a[1][1] = acc[ai][1][m][1]; row(a, ai, m, u, wr, wc, fr, fq); } }

struct EpiIn {
    static constexpr bool PERM = true, AFTER_DRAIN = false;
    float* ZA; bf16_t* ZB; const float* CS;
    __device__ __forceinline__ void row(const f32x4 (&a)[2][2], int ai, int m, const Unit& u, int wr, int wc, int fr, int fq) const {
        const int row = u.pm * BM + wr * 64 + fr + ai * HALF + m * 16;
        if (u.pn < 14) {
#pragma unroll
            for (int bj = 0; bj < 2; ++bj) { const int col = u.pn * BM + bj * HALF + wc * 32 + 8 * fq;
                if (col < E_RC) { float* p = ZA + (size_t)row * E_RC + col; *(f32x4*)p = a[bj][0]; *(f32x4*)(p + 4) = a[bj][1]; } }
        } else {
            const int ct = (u.pn - 14) * BM;
            const int tp = row < E_MP ? row % E_TP : (row < E_MR ? E_TP + ((row - E_MP) & 3) : 0);
#pragma unroll
            for (int bj = 0; bj < 2; ++bj) { const int c = ct + bj * HALF + wc * 32 + 8 * fq;
                f32x4 v0 = a[bj][0], v1 = a[bj][1];
                if (c < 2048) {
                    const float* cs = CS + ((size_t)tp * 128 + ((c & 255) >> 1)) * 2;
                    const f32x4 t0 = *(const f32x4*)cs, t1 = *(const f32x4*)(cs + 4);
                    const float sc = c >= 1024 ? 0.0625f : 1.0f;
                    f32x4 w0, w1;
                    w0[0] = (v0[0] * t0[0] - v0[1] * t0[1]) * sc; w0[1] = (v0[0] * t0[1] + v0[1] * t0[0]) * sc;
                    w0[2] = (v0[2] * t0[2] - v0[3] * t0[3]) * sc; w0[3] = (v0[2] * t0[3] + v0[3] * t0[2]) * sc;
                    w1[0] = (v1[0] * t1[0] - v1[1] * t1[1]) * sc; w1[1] = (v1[0] * t1[1] + v1[1] * t1[0]) * sc;
                    w1[2] = (v1[2] * t1[2] - v1[3] * t1[3]) * sc; w1[3] = (v1[2] * t1[3] + v1[3] * t1[2]) * sc;
                    v0 = w0; v1 = w1;
                }
                u32x4 w; w.x = cvt_pk_bf16(v0[0], v0[1]); w.y = cvt_pk_bf16(v0[2], v0[3]); w.z = cvt_pk_bf16(v1[0], v1[1]); w.w = cvt_pk_bf16(v1[2], v1[3]);
                *(u32x4*)(ZB + (size_t)row * 4096 + c) = w; }
        }
    }
    EPI_WALK()
};

__device__ __forceinline__ const float* xsrc_row(const float* xp, const float* xs, const float* meta, int row) {
    if (row < E_MP) { const int b = row / E_TP, p = row - b * E_TP; return p < 16 ? meta + (size_t)p * 2048 : xp + ((size_t)b * 2048 + (p - 16)) * 2048; }
    if (row < E_MR) return xs + (size_t)(row - E_MP) * 2048;
    return nullptr;
}

struct EpiOut {
    static constexpr bool PERM = true, AFTER_DRAIN = false;
    float* H; const float* xp; const float* xs; const float* meta;
    __device__ __forceinline__ void row(const f32x4 (&a)[2][2], int ai, int m, const Unit& u, int wr, int wc, int fr, int fq) const {
        const int row = u.pm * BM + wr * 64 + fr + ai * HALF + m * 16; const float* xr = xsrc_row(xp, xs, meta, row);
#pragma unroll
        for (int bj = 0; bj < 2; ++bj) { const int col = u.pn * BM + bj * HALF + wc * 32 + 8 * fq;
            f32x4 v0 = a[bj][0], v1 = a[bj][1];
            if (xr) { v0 += *(const f32x4*)(xr + col); v1 += *(const f32x4*)(xr + col + 4); }
            float* p = H + (size_t)row * 2048 + col; *(f32x4*)p = v0; *(f32x4*)(p + 4) = v1; }
    }
    EPI_WALK()
};

__device__ __forceinline__ float silu_f(float x) { return x / (1.0f + __expf(-x)); }

struct EpiGateUp {
    static constexpr bool PERM = true, AFTER_DRAIN = false;
    bf16_t* ACT;
    __device__ __forceinline__ void row(const f32x4 (&a)[2][2], int ai, int m, const Unit& u, int wr, int wc, int fr, int fq) const {
        const int row = u.pm * BM + wr * 64 + fr + ai * HALF + m * 16; const int col = u.pn * HALF + wc * 32 + 8 * fq;
        const f32x4 g0 = a[0][0], g1 = a[0][1], u0 = a[1][0], u1 = a[1][1];
        u32x4 w;
        w.x = cvt_pk_bf16(silu_f(g0[0]) * u0[0], silu_f(g0[1]) * u0[1]); w.y = cvt_pk_bf16(silu_f(g0[2]) * u0[2], silu_f(g0[3]) * u0[3]);
        w.z = cvt_pk_bf16(silu_f(g1[0]) * u1[0], silu_f(g1[1]) * u1[1]); w.w = cvt_pk_bf16(silu_f(g1[2]) * u1[2], silu_f(g1[3]) * u1[3]);
        *(u32x4*)(ACT + (size_t)row * 5632 + col) = w;
    }
    EPI_WALK()
};

struct EpiDown {
    static constexpr bool PERM = true, AFTER_DRAIN = false;
    float* H;
    __device__ __forceinline__ void row(const f32x4 (&a)[2][2], int ai, int m, const Unit& u, int wr, int wc, int fr, int fq) const {
        const int row = u.pm * BM + wr * 64 + fr + ai * HALF + m * 16;
#pragma unroll
        for (int bj = 0; bj < 2; ++bj) { const int col = u.pn * BM + bj * HALF + wc * 32 + 8 * fq;
            float* p = H + (size_t)row * 2048 + col;
            const f32x4 v0 = *(const f32x4*)p + a[bj][0], v1 = *(const f32x4*)(p + 4) + a[bj][1];
            *(f32x4*)p = v0; *(f32x4*)(p + 4) = v1; }
    }
    EPI_WALK()
};

struct SplitOrder {
    StaticOrder so; int base, ntail, nsl;
    __device__ __forceinline__ bool next(int i, Unit& u) const { const int v = i * so.G + so.c; if (v >= ntail * nsl) return false; so.map(base + v / nsl, u); u.ks = v % nsl; u.aux = v; return true; }
    __device__ __forceinline__ void a_ready(const Unit&) const {}
    __device__ __forceinline__ void done(const Unit&) const {}
};
struct EpiPartial {
    static constexpr bool PERM = true, AFTER_DRAIN = false;
    float* P;
    __device__ __forceinline__ void operator()(const f32x4 (&acc)[2][2][4][2], const Unit& u, int wr, int wc, int fr, int fq) const {
        f32x4* p = (f32x4*)P + (size_t)u.aux * 32 * 512 + threadIdx.x;
#pragma unroll
        for (int ai = 0; ai < 2; ++ai)
#pragma unroll
            for (int bj = 0; bj < 2; ++bj)
#pragma unroll
                for (int m = 0; m < 4; ++m)
#pragma unroll
                    for (int n = 0; n < 2; ++n) p[(size_t)((((ai * 2 + bj) * 4 + m) * 2 + n)) * 512] = acc[ai][bj][m][n];
    }
};
template <class Epi, class Sched, bool ALIGN_EPI = false, bool SP2 = false>
__device__ __forceinline__ void gemm_phase(PG8_LAS unsigned char* lds, const Gemm g, const Sched& S, const Epi& E) {
    const int tid = threadIdx.x, wid = __builtin_amdgcn_readfirstlane(tid >> 6), lane = tid & 63, wr = wid >> 2, wc = wid & 3, fr = lane & 15, fq = lane >> 4;
    const int K = g.K, nt = K / BK, KL = g.ld;
    unsigned voffA[2], voffB[2];
#pragma unroll
    for (int i = 0; i < 2; ++i) { int R, C; stage_rc(tid * 16 + i * 8192, R, C); const int Rb = Epi::PERM ? ((R & ~31) + perm32(R & 31)) : R;
        voffA[i] = (unsigned)(R * KL + C) * 2u; voffB[i] = (unsigned)(Rb * KL + C) * 2u; }
    const size_t kstep = (size_t)(BK * 2);
    const size_t hstep = (size_t)HALF * KL * 2;
    const size_t tstep = 2 * hstep;
    const unsigned ldsw = (unsigned)wid * 1024u;
    const int aoff = lds_byte(wr * 64 + fr, fq * 8), boff = lds_byte(wc * 32 + fr, fq * 8);
#define PG8_SA(b, h) (((b) * 2 + (h)) * HTB)
#define PG8_SB(b, h) ((4 + (b) * 2 + (h)) * HTB)
#define PG8_STAGE(bufoff, gbase, voff) do { _Pragma("unroll") for (int _i = 0; _i < 2; ++_i) \
        __builtin_amdgcn_global_load_lds((const unsigned*)((const char*)(gbase) + (voff)[_i]), (PG8_LAS unsigned*)(lds + (bufoff) + ldsw + _i * 8192), 16, 0, 0); } while (0)
#define PG8_LDA(dst, b, h) do { _Pragma("unroll") for (int m = 0; m < 4; ++m) _Pragma("unroll") for (int k = 0; k < 2; ++k) dst[m][k] = *(const PG8_LAS bf16x8*)(lds + PG8_SA(b, h) + aoff + m * 2048 + k * 1024); } while (0)
#define PG8_LDB(dst, b, h) do { _Pragma("unroll") for (int n = 0; n < 2; ++n) _Pragma("unroll") for (int k = 0; k < 2; ++k) dst[n][k] = *(const PG8_LAS bf16x8*)(lds + PG8_SB(b, h) + boff + n * 2048 + k * 1024); } while (0)
#define PG8_MMA(ai, bj, At, Bt) do { __builtin_amdgcn_s_setprio(1); _Pragma("unroll") for (int m = 0; m < 4; ++m) _Pragma("unroll") for (int n = 0; n < 2; ++n) _Pragma("unroll") for (int k = 0; k < 2; ++k) \
        acc[ai][bj][m][n] = __builtin_amdgcn_mfma_f32_16x16x32_bf16(Bt[n][k], At[m][k], acc[ai][bj][m][n], 0, 0, 0); __builtin_amdgcn_s_setprio(0); } while (0)
#define PG8_WAIT_V(n) asm volatile("s_waitcnt vmcnt(" #n ")" ::: "memory")
#define PG8_WAIT_L(n) asm volatile("s_waitcnt lgkmcnt(" #n ")" ::: "memory")
#define PG8_BAR __builtin_amdgcn_s_barrier()
#define PG8_SCHED __builtin_amdgcn_sched_barrier(0)
    Unit cur, nxt; int ui = 0;
    if (!S.next(0, cur)) return;
    f32x4 acc[2][2][4][2];
#pragma unroll
    for (int a = 0; a < 2; ++a)
#pragma unroll
        for (int b = 0; b < 2; ++b)
#pragma unroll
            for (int m = 0; m < 4; ++m)
#pragma unroll
                for (int n = 0; n < 2; ++n) acc[a][b][m][n] = (f32x4){0.f, 0.f, 0.f, 0.f};
    bf16x8 At[4][2], B0[2][2], B1[2][2];
    const char* cA = (const char*)g.A + (size_t)cur.pm * tstep + (size_t)cur.ks * K * 2; const char* cB = (const char*)g.Bt + (size_t)cur.pn * tstep + (size_t)cur.ks * K * 2;
    S.a_ready(cur);
    if constexpr (SP2) {
        PG8_STAGE(PG8_SB(0, 0), cB, voffB); PG8_STAGE(PG8_SB(0, 1), cB + hstep, voffB); PG8_STAGE(PG8_SA(0, 0), cA, voffA); PG8_STAGE(PG8_SA(0, 1), cA + hstep, voffA);
        if (wr == 1) PG8_BAR;
        PG8_WAIT_V(2); PG8_BAR;
        PG8_STAGE(PG8_SB(1, 0), cB + kstep, voffB); PG8_STAGE(PG8_SA(1, 0), cA + kstep, voffA); PG8_STAGE(PG8_SB(1, 1), cB + hstep + kstep, voffB);
        PG8_WAIT_V(6); PG8_BAR;
    } else {
        PG8_STAGE(PG8_SB(0, 0), cB, voffB); PG8_STAGE(PG8_SA(0, 0), cA, voffA); PG8_STAGE(PG8_SB(0, 1), cB + hstep, voffB); PG8_STAGE(PG8_SA(0, 1), cA + hstep, voffA);
        if (wr == 1) PG8_BAR;
        PG8_WAIT_V(4); PG8_BAR;
        PG8_STAGE(PG8_SB(1, 0), cB + kstep, voffB); PG8_STAGE(PG8_SA(1, 0), cA + kstep, voffA); PG8_STAGE(PG8_SB(1, 1), cB + hstep + kstep, voffB);
        PG8_WAIT_V(6); PG8_BAR;
    }
    for (;;) {
        const bool has_next = S.next(ui + 1, nxt);
        const char* nA = has_next ? (const char*)g.A + (size_t)nxt.pm * tstep + (size_t)nxt.ks * K * 2 : cA; const char* nB = has_next ? (const char*)g.Bt + (size_t)nxt.pn * tstep + (size_t)nxt.ks * K * 2 : cB;
        for (int t = 0; t < nt; t += 2) {
            const bool last = (t == nt - 2);
            const char* a1 = cA + (size_t)(t + 1) * kstep;
            const char* a2 = last ? nA : cA + (size_t)(t + 2) * kstep; const char* b2 = last ? nB : cB + (size_t)(t + 2) * kstep;
            const char* a3 = a2 + kstep; const char* b3 = b2 + kstep;
            if (last && has_next) S.a_ready(nxt);
            if constexpr (SP2) {
            PG8_LDB(B0, 0, 0); PG8_LDB(B1, 0, 1); PG8_SCHED; PG8_LDA(At, 0, 0); PG8_STAGE(PG8_SA(1, 1), a1 + hstep, voffA);
            PG8_WAIT_V(8); PG8_WAIT_L(0); PG8_BAR; PG8_MMA(0, 0, At, B0); PG8_MMA(0, 1, At, B1); PG8_BAR; PG8_SCHED;
            PG8_LDA(At, 0, 1); PG8_STAGE(PG8_SB(0, 0), b2, voffB); PG8_STAGE(PG8_SB(0, 1), b2 + hstep, voffB); PG8_STAGE(PG8_SA(0, 0), a2, voffA);
            PG8_WAIT_V(8); PG8_WAIT_L(0); PG8_BAR; PG8_MMA(1, 0, At, B0); PG8_MMA(1, 1, At, B1); PG8_BAR; PG8_SCHED;
            PG8_LDB(B0, 1, 0); PG8_LDB(B1, 1, 1); PG8_SCHED; PG8_LDA(At, 1, 0); PG8_STAGE(PG8_SA(0, 1), a2 + hstep, voffA);
            PG8_WAIT_V(8); PG8_WAIT_L(0); PG8_BAR; PG8_MMA(0, 0, At, B0); PG8_MMA(0, 1, At, B1); PG8_BAR; PG8_SCHED;
            PG8_LDA(At, 1, 1); PG8_STAGE(PG8_SB(1, 0), b3, voffB); PG8_STAGE(PG8_SB(1, 1), b3 + hstep, voffB); PG8_STAGE(PG8_SA(1, 0), a3, voffA);
            PG8_WAIT_V(8); PG8_WAIT_L(0); PG8_BAR; PG8_MMA(1, 0, At, B0); PG8_MMA(1, 1, At, B1); PG8_BAR; PG8_SCHED;
            } else {
            PG8_LDB(B0, 0, 0); PG8_SCHED; PG8_LDA(At, 0, 0); PG8_STAGE(PG8_SA(1, 1), a1 + hstep, voffA);
            PG8_WAIT_L(8); PG8_BAR; PG8_WAIT_L(0); PG8_MMA(0, 0, At, B0); PG8_BAR; PG8_SCHED;
            PG8_LDB(B1, 0, 1); PG8_STAGE(PG8_SB(0, 0), b2, voffB);
            PG8_BAR; PG8_WAIT_L(0); PG8_MMA(0, 1, At, B1); PG8_BAR;
            PG8_LDA(At, 0, 1); PG8_STAGE(PG8_SA(0, 0), a2, voffA);
            PG8_BAR; PG8_WAIT_L(0); PG8_MMA(1, 0, At, B0); PG8_BAR; PG8_SCHED;
            PG8_STAGE(PG8_SB(0, 1), b2 + hstep, voffB);
            PG8_WAIT_V(6); PG8_BAR; PG8_MMA(1, 1, At, B1); PG8_BAR;
            PG8_LDB(B0, 1, 0); PG8_SCHED; PG8_LDA(At, 1, 0); PG8_STAGE(PG8_SA(0, 1), a2 + hstep, voffA);
            PG8_WAIT_L(8); PG8_BAR; PG8_WAIT_L(0); PG8_MMA(0, 0, At, B0); PG8_BAR; PG8_SCHED;
            PG8_LDB(B1, 1, 1); PG8_STAGE(PG8_SB(1, 0), b3, voffB);
            PG8_BAR; PG8_WAIT_L(0); PG8_MMA(0, 1, At, B1); PG8_BAR;
            PG8_LDA(At, 1, 1); PG8_STAGE(PG8_SA(1, 0), a3, voffA);
            PG8_BAR; PG8_WAIT_L(0); PG8_MMA(1, 0, At, B0); PG8_BAR; PG8_SCHED;
            PG8_STAGE(PG8_SB(1, 1), b3 + hstep, voffB);
            PG8_WAIT_V(6); PG8_BAR; PG8_MMA(1, 1, At, B1); PG8_BAR;
            }
        }
        if constexpr (ALIGN_EPI) { if (wr == 0) PG8_BAR; }
        if constexpr (!Epi::AFTER_DRAIN) { E(acc, cur, wr, wc, fr, fq); S.done(cur); }
        if (!has_next) break;
#pragma unroll
        for (int a = 0; a < 2; ++a)
#pragma unroll
            for (int b = 0; b < 2; ++b)
#pragma unroll
                for (int m = 0; m < 4; ++m)
#pragma unroll
                    for (int n = 0; n < 2; ++n) acc[a][b][m][n] = (f32x4){0.f, 0.f, 0.f, 0.f};
        cur = nxt; cA = nA; cB = nB; ++ui;
        if constexpr (ALIGN_EPI) { if (wr == 1) PG8_BAR; }
    }
    PG8_WAIT_V(0);
    if constexpr (!ALIGN_EPI) { if (wr == 0) PG8_BAR; }
    PG8_BAR;
    if constexpr (Epi::AFTER_DRAIN) { E.fused(acc, cur, wr, wc, fr, fq, lds, wid, lane); S.done(cur); }
#undef PG8_SA
#undef PG8_SB
#undef PG8_STAGE
#undef PG8_LDA
#undef PG8_LDB
#undef PG8_MMA
#undef PG8_WAIT_V
#undef PG8_WAIT_L
#undef PG8_BAR
#undef PG8_SCHED
}
}

constexpr int DM = 2048, NB = 4, SEQ = 2048, TP = 2064, NS = 128, TS = 4;
constexpr int MP = NB * TP;
constexpr int MR = MP + NS * TS;
constexpr int MPAD = 8960;
constexpr int RC = 3360;
constexpr int NIN = 7680;
constexpr int DFF = 5632;
constexpr int NTP = 2068;

constexpr size_t MiB = 1u << 20;
constexpr size_t ARR = (size_t)MR * 1024 * 4;
constexpr size_t WS_LT = 128 * 1024;
constexpr size_t WS_CS = 1 * MiB, WS_BON = 3 * MiB + 256 * 1024, WS_WOUT = 4 * MiB, WS_XN = 12 * MiB, WS_ZA = 47 * MiB, WS_ZB = 162 * MiB;
constexpr size_t WS_W = 232 * MiB, WS_RKAB = WS_W + ARR, WS_G = WS_RKAB + 2 * ARR, WS_O = WS_G + ARR, WS_ORET = WS_O + ARR;
constexpr size_t WS_R = WS_W;
constexpr size_t WS_WIN = 232 * MiB;
constexpr size_t WS_H = 47 * MiB, WS_WGU = WS_ORET + (size_t)MP * 1024 * 4, WS_WDN = WS_WGU + 44 * MiB, WS_ACT = 232 * MiB;
constexpr size_t WS_PART = WS_G;
constexpr size_t WS_END = WS_WDN + 22 * MiB;
static_assert(WS_END <= 512 * MiB, "ws map");
static_assert(WS_ZA + (size_t)MPAD * RC * 4 <= WS_ZB && WS_ZB + (size_t)MPAD * 4096 * 2 <= WS_R && WS_ACT + (size_t)MPAD * 5632 * 2 <= WS_G && WS_PART + 52 * MiB <= WS_WGU, "ws map 2");
static_assert(WS_CS + (size_t)NTP * 128 * 8 <= WS_BON && WS_BON + (size_t)MR * 16 * 4 <= WS_WOUT, "ws map 3");

constexpr size_t OUT_YP = 0, OUT_YS = 16777216, OUT_SHP = 17825792, OUT_RWP = 17839232, OUT_RTP = 18101376, OUT_SHS = 19149952, OUT_RWS = 19580032, OUT_RTS = 27968640;

constexpr int LDS_BYTES = 147456;
constexpr int NPH = 10;

#define LAS __attribute__((address_space(3)))
typedef unsigned short bf16;
typedef unsigned v4u __attribute__((ext_vector_type(4)));
typedef unsigned v2u __attribute__((ext_vector_type(2)));
typedef float f32x4 __attribute__((ext_vector_type(4)));
typedef float f32x2 __attribute__((ext_vector_type(2)));
typedef short bf16x8 __attribute__((ext_vector_type(8)));

__device__ __forceinline__ unsigned f2bf(float f) { unsigned u = __builtin_bit_cast(unsigned, f); return (u + 0x7fffu + ((u >> 16) & 1u)) >> 16; }
__device__ __forceinline__ unsigned pk2(float lo, float hi) { return f2bf(lo) | (f2bf(hi) << 16); }
__device__ __forceinline__ float bf2f(unsigned b) { return __builtin_bit_cast(float, b << 16); }
__device__ __forceinline__ float wave_sum(float v) {
#pragma unroll
    for (int o = 1; o < 64; o <<= 1) v += __shfl_xor(v, o);
    return v;
}
__device__ __forceinline__ float half_sum(float v) {
#pragma unroll
    for (int o = 1; o < 32; o <<= 1) v += __shfl_xor(v, o);
    return v;
}
#define DPP_ROR(x, n) __builtin_bit_cast(float, __builtin_amdgcn_update_dpp(0, __builtin_bit_cast(int, (x)), 0x120 + (n), 0xf, 0xf, false))
__device__ __forceinline__ float rowsum16(float x) {
    x += DPP_ROR(x, 8); x += DPP_ROR(x, 4); x += DPP_ROR(x, 2); x += DPP_ROR(x, 1);
    return x;
}

__device__ __forceinline__ float fma_s(float a, float b, float c) { float d; asm("v_fma_f32 %0, %1, %2, %3" : "=v"(d) : "v"(a), "v"(b), "v"(c)); return d; }
__device__ __forceinline__ float mul_s(float a, float b) { float d; asm("v_mul_f32 %0, %1, %2" : "=v"(d) : "v"(a), "v"(b)); return d; }
__device__ __forceinline__ float add_s(float a, float b) { float d; asm("v_add_f32 %0, %1, %2" : "=v"(d) : "v"(a), "v"(b)); return d; }
#define SCAN_STEP(S, r4, w4, k4, a4, b4, vi, ov) do { \
    const float sa_ = rowsum16(add_s(fma_s(S.y, a4.y, mul_s(S.x, a4.x)), fma_s(S.w, a4.w, mul_s(S.z, a4.z)))); \
    S.x = fma_s(S.x, w4.x, fma_s(sa_, b4.x, mul_s(vi, k4.x))); S.y = fma_s(S.y, w4.y, fma_s(sa_, b4.y, mul_s(vi, k4.y))); \
    S.z = fma_s(S.z, w4.z, fma_s(sa_, b4.z, mul_s(vi, k4.z))); S.w = fma_s(S.w, w4.w, fma_s(sa_, b4.w, mul_s(vi, k4.w))); \
    ov = rowsum16(add_s(fma_s(S.y, r4.y, mul_s(S.x, r4.x)), fma_s(S.w, r4.w, mul_s(S.z, r4.z)))); } while (0)

__device__ __forceinline__ float fexp(float x) { return __expf(x); }
__device__ __forceinline__ float frcp(float x) { return __builtin_amdgcn_rcpf(x); }
__device__ __forceinline__ float fsig(float x) { return frcp(1.0f + __expf(-x)); }
__device__ __forceinline__ float ftanh(float x) { return 1.0f - 2.0f * frcp(1.0f + __expf(2.0f * x)); }
__device__ __forceinline__ float sigmoid_f(float x) { return 1.0f / (1.0f + expf(-x)); }

struct Args { const float* in[25]; float* out; unsigned char* ws; int ph_lo, ph_hi, sub, pad; };

__device__ __forceinline__ void transpose_item(const float* W, int K, int N, bf16* WT, int mode, LAS float* scr, int item, int lane) {
    const int nblk = N / 32, kb = item / nblk, nb = item % nblk, k0 = 64 * kb, n0 = 32 * nb;
#pragma unroll
    for (int i = 0; i < 32; ++i) { const int kk = 2 * i + (lane >> 5); scr[kk * 33 + (lane & 31)] = W[(size_t)(k0 + kk) * N + n0 + (lane & 31)]; }
    asm volatile("s_waitcnt lgkmcnt(0)" ::: "memory");
    int r0 = n0;
    if (mode == 1) r0 = n0 < RC ? n0 : n0 + 224;
    else if (mode == 2) r0 = 256 * (n0 >> 7) + (n0 & 127);
    else if (mode == 3) r0 = 256 * (n0 >> 7) + (n0 & 127) + 128;
    const int c = lane & 7;
#pragma unroll
    for (int j = 0; j < 4; ++j) { const int n = (lane >> 3) + 8 * j; const LAS float* s = scr + (8 * c) * 33 + n;
        v4u o; o.x = pk2(s[0 * 33], s[1 * 33]); o.y = pk2(s[2 * 33], s[3 * 33]); o.z = pk2(s[4 * 33], s[5 * 33]); o.w = pk2(s[6 * 33], s[7 * 33]);
        *(v4u*)(WT + (size_t)(r0 + n) * K + k0 + 8 * c) = o; }
    asm volatile("s_waitcnt lgkmcnt(0)" ::: "memory");
}
__device__ __forceinline__ void rms_row_bf16(const float* xrow, const float* gain, bf16* orow, int lane) {
    f32x4 v[8]; float s = 0.f;
#pragma unroll
    for (int j = 0; j < 8; ++j) { v[j] = *(const f32x4*)(xrow + 4 * lane + 256 * j); s += (v[j].x * v[j].x + v[j].y * v[j].y) + (v[j].z * v[j].z + v[j].w * v[j].w); }
    const float rs = 1.0f / sqrtf(wave_sum(s) * (1.0f / 2048.0f) + 1e-6f);
#pragma unroll
    for (int j = 0; j < 8; ++j) { const f32x4 g = *(const f32x4*)(gain + 4 * lane + 256 * j);
        v2u o; o.x = pk2(v[j].x * rs * g.x, v[j].y * rs * g.y); o.y = pk2(v[j].z * rs * g.z, v[j].w * rs * g.w);
        *(v2u*)(orow + 4 * lane + 256 * j) = o; }
}
__device__ __forceinline__ void rms_rows2_bf16(const float* x0, const float* x1, const float* gain, bf16* o0, bf16* o1, int lane) {
    f32x4 v[8], u[8]; float s = 0.f, t = 0.f;
#pragma unroll
    for (int j = 0; j < 8; ++j) { v[j] = *(const f32x4*)(x0 + 4 * lane + 256 * j); u[j] = *(const f32x4*)(x1 + 4 * lane + 256 * j); }
#pragma unroll
    for (int j = 0; j < 8; ++j) { s += (v[j].x * v[j].x + v[j].y * v[j].y) + (v[j].z * v[j].z + v[j].w * v[j].w); t += (u[j].x * u[j].x + u[j].y * u[j].y) + (u[j].z * u[j].z + u[j].w * u[j].w); }
    const float rs = 1.0f / sqrtf(wave_sum(s) * (1.0f / 2048.0f) + 1e-6f), rt = 1.0f / sqrtf(wave_sum(t) * (1.0f / 2048.0f) + 1e-6f);
#pragma unroll
    for (int j = 0; j < 8; ++j) { const f32x4 g = *(const f32x4*)(gain + 4 * lane + 256 * j);
        v2u a; a.x = pk2(v[j].x * rs * g.x, v[j].y * rs * g.y); a.y = pk2(v[j].z * rs * g.z, v[j].w * rs * g.w); *(v2u*)(o0 + 4 * lane + 256 * j) = a;
        v2u b; b.x = pk2(u[j].x * rt * g.x, u[j].y * rt * g.y); b.y = pk2(u[j].z * rt * g.z, u[j].w * rt * g.w); *(v2u*)(o1 + 4 * lane + 256 * j) = b; }
}
__device__ __forceinline__ void zero_row_bf16(bf16* orow, int lane) {
#pragma unroll
    for (int j = 0; j < 8; ++j) *(v2u*)(orow + 4 * lane + 256 * j) = (v2u){0u, 0u};
}
__device__ __forceinline__ float zprev_val(const float* ZA, const float* sshift, int row, int col) {
    if (row < MP) { const int p = row % TP; return p == 0 ? 0.f : ZA[(size_t)(row - 1) * RC + col]; }
    const int r = row - MP; return (r & 3) == 0 ? sshift[(size_t)(r >> 2) * RC + col] : ZA[(size_t)(row - 1) * RC + col];
}

template <int MT, int NT, int KS>
__device__ __forceinline__ void wave_mma(f32x4 (&acc)[MT][NT], const LAS unsigned char* A, int lda, const LAS unsigned char* B, int ldb, int fr, int fq) {
#pragma unroll 2
    for (int ks = 0; ks < KS; ++ks) {
        bf16x8 a[MT], b[NT];
#pragma unroll
        for (int mi = 0; mi < MT; ++mi) a[mi] = *(const LAS bf16x8*)(A + (mi * 16 + fr) * lda + (ks * 32 + fq * 8) * 2);
#pragma unroll
        for (int ni = 0; ni < NT; ++ni) b[ni] = *(const LAS bf16x8*)(B + (ni * 16 + fr) * ldb + (ks * 32 + fq * 8) * 2);
#pragma unroll
        for (int mi = 0; mi < MT; ++mi)
#pragma unroll
            for (int ni = 0; ni < NT; ++ni) acc[mi][ni] = __builtin_amdgcn_mfma_f32_16x16x32_bf16(a[mi], b[ni], acc[mi][ni], 0, 0, 0);
    }
}

__device__ __forceinline__ float ret_lg2(int h) { return h == 0 ? -0.04580368961312479f : (h == 1 ? -0.02272007650008353f : (h == 2 ? -0.011315313227834146f : -0.005646563141142063f)); }

__device__ __forceinline__ void ret_prompt_unit(LAS unsigned char* L, const bf16* ZB, float* ORET, float* retp, int unit, int tid) {
    const int lane = tid & 63, wave = tid >> 6, fr = lane & 15, fq = lane >> 4;
    const int b = unit >> 5, h = (unit >> 3) & 3, es = unit & 7;
    const float lg2 = ret_lg2(h);
    LAS unsigned char* Q = L; LAS unsigned char* R2 = L + 67584; LAS unsigned char* VT = L + 137216;
    LAS unsigned char* P = R2; LAS unsigned char* ST = R2 + 34816; LAS unsigned char* KT = R2;
    f32x4 S[2][2];
#pragma unroll
    for (int a = 0; a < 2; ++a)
#pragma unroll
        for (int c = 0; c < 2; ++c) S[a][c] = (f32x4){0.f, 0.f, 0.f, 0.f};
    v4u qn[8], kn[8], vn;
    const int vj = tid & 127, veg = tid >> 7;
#define RET_LOAD(ch_) do { const int C_ = (ch_) == 0 ? 16 : 128, rb_ = b * TP + ((ch_) == 0 ? 0 : 16 + ((ch_) - 1) * 128); \
        const bf16* src_ = ZB + (size_t)(rb_ + vj) * 4096 + h * 256 + veg * 8; \
        _Pragma("unroll") for (int it = 0; it < 8; ++it) { qn[it] = (v4u){0u, 0u, 0u, 0u}; kn[it] = qn[it]; \
            if (vj < C_) { qn[it] = *(const v4u*)(src_ + it * 32); kn[it] = *(const v4u*)(src_ + 1024 + it * 32); } } \
        vn = (v4u){0u, 0u, 0u, 0u}; if (vj < C_) vn = *(const v4u*)(src_ + 2048 + es * 32); } while (0)
    RET_LOAD(0);
    for (int ch = 0; ch < 17; ++ch) {
        const int C = ch == 0 ? 16 : 128, tok0 = ch == 0 ? 0 : 16 + (ch - 1) * 128, rowbase = b * TP + tok0;
#pragma unroll
        for (int it = 0; it < 8; ++it) {
            *(LAS v4u*)(Q + vj * 528 + veg * 16 + it * 64) = qn[it];
            *(LAS v4u*)(R2 + vj * 528 + veg * 16 + it * 64) = kn[it]; }
#pragma unroll
        for (int x = 0; x < 4; ++x) { const unsigned w = vn[x];
            *(LAS unsigned short*)(VT + (veg * 8 + 2 * x) * 272 + vj * 2) = (unsigned short)(w & 0xffffu);
            *(LAS unsigned short*)(VT + (veg * 8 + 2 * x + 1) * 272 + vj * 2) = (unsigned short)(w >> 16); }
        __syncthreads();
        f32x4 sc[4][2];
#pragma unroll
        for (int a = 0; a < 4; ++a)
#pragma unroll
            for (int c = 0; c < 2; ++c) sc[a][c] = (f32x4){0.f, 0.f, 0.f, 0.f};
        const int mt0 = (wave >> 1) * 2, nt0 = (wave & 1) * 4;
        wave_mma<4, 2, 8>(sc, R2 + nt0 * 16 * 528, 528, Q + mt0 * 16 * 528, 528, fr, fq);
        __syncthreads();
        float lg2v = lg2; asm volatile("" : "+v"(lg2v));
        const float gi1 = exp2f(-lg2v), gi2 = gi1 * gi1, gi3 = gi2 * gi1;
#pragma unroll
        for (int mi = 0; mi < 4; ++mi)
#pragma unroll
            for (int ni = 0; ni < 2; ++ni) { const int j0 = (nt0 + mi) * 16 + 4 * fq, i = (mt0 + ni) * 16 + fr;
                const float e0 = exp2f(lg2v * (float)(i - j0));
                float pv[4];
                pv[0] = i >= j0 ? sc[mi][ni][0] * e0 : 0.f; pv[1] = i >= j0 + 1 ? sc[mi][ni][1] * (e0 * gi1) : 0.f;
                pv[2] = i >= j0 + 2 ? sc[mi][ni][2] * (e0 * gi2) : 0.f; pv[3] = i >= j0 + 3 ? sc[mi][ni][3] * (e0 * gi3) : 0.f;
                v2u w; w.x = pk2(pv[0], pv[1]); w.y = pk2(pv[2], pv[3]);
                *(LAS v2u*)(P + i * 272 + j0 * 2) = w; }
#pragma unroll
        for (int dt = 0; dt < 2; ++dt)
#pragma unroll
            for (int et = 0; et < 2; ++et) { const int d = (2 * wave + dt) * 16 + 4 * fq, e = et * 16 + fr;
                v2u w; w.x = pk2(S[dt][et][0], S[dt][et][1]); w.y = pk2(S[dt][et][2], S[dt][et][3]);
                *(LAS v2u*)(ST + e * 528 + d * 2) = w; }
        __syncthreads();
        f32x4 o1[1][2], o2[1][2];
        o1[0][0] = o1[0][1] = o2[0][0] = o2[0][1] = (f32x4){0.f, 0.f, 0.f, 0.f};
        wave_mma<1, 2, 4>(o1, P + wave * 16 * 272, 272, VT, 272, fr, fq);
        wave_mma<1, 2, 8>(o2, Q + wave * 16 * 528, 528, ST, 528, fr, fq);
#pragma unroll
        for (int ni = 0; ni < 2; ++ni)
#pragma unroll
            for (int r = 0; r < 4; ++r) { const int i = wave * 16 + 4 * fq + r, e = ni * 16 + fr;
                if (i < C) ORET[(size_t)(rowbase + i) * 1024 + h * 256 + es * 32 + e] = o1[0][ni][r] + exp2f(lg2v * (float)(i + 1)) * o2[0][ni][r]; }
        __syncthreads();
        const float sdec = vj < C ? exp2f(lg2v * (float)(C - 1 - vj)) : 0.f;
#pragma unroll
        for (int it = 0; it < 8; ++it) { const int j = vj, db = veg + 4 * it;
#pragma unroll
            for (int x = 0; x < 4; ++x) { const unsigned w = kn[it][x];
                *(LAS unsigned short*)(KT + (db * 8 + 2 * x) * 272 + j * 2) = (unsigned short)f2bf(bf2f(w & 0xffffu) * sdec);
                *(LAS unsigned short*)(KT + (db * 8 + 2 * x + 1) * 272 + j * 2) = (unsigned short)f2bf(bf2f(w >> 16) * sdec); } }
        if (ch + 1 < 17) RET_LOAD(ch + 1);
        __syncthreads();
        const float gC = exp2f(lg2 * (float)C);
#pragma unroll
        for (int a = 0; a < 2; ++a)
#pragma unroll
            for (int c = 0; c < 2; ++c) S[a][c] *= gC;
        wave_mma<2, 2, 4>(S, KT + (2 * wave) * 16 * 272, 272, VT, 272, fr, fq);
        __syncthreads();
    }
#undef RET_LOAD
#pragma unroll
    for (int dt = 0; dt < 2; ++dt)
#pragma unroll
        for (int et = 0; et < 2; ++et)
#pragma unroll
            for (int r = 0; r < 4; ++r) { const int d = (2 * wave + dt) * 16 + 4 * fq + r, e = es * 32 + et * 16 + fr;
                retp[((size_t)(b * 4 + h) * 256 + d) * 256 + e] = S[dt][et][r]; }
}

__device__ __forceinline__ void ret_sample_unit(LAS unsigned char* L, const bf16* ZB, const float* sret, float* rets, bf16* OAB, int unit, int tid) {
    const int lane = tid & 63, wave = tid >> 6;
    const int s = unit >> 2, h = unit & 3;
    const float lg2 = ret_lg2(h);
    LAS float* qs = (LAS float*)L;
    LAS float* ks = qs + 1024;
    LAS float* qr = ks + 1024;
    LAS float* kr = qr + 1024;
    LAS float* scs = kr + 1024;
    LAS float* part = scs + 16;
    LAS float* red = part + 2048;
    const int rowb = MP + 4 * s;
    for (int idx = tid; idx < 1024; idx += 512) { const int i = idx >> 8, d = idx & 255;
        const bf16* src = ZB + (size_t)(rowb + i) * 4096 + h * 256 + d;
        const float q = bf2f(src[0]), k = bf2f(src[1024]);
        qr[idx] = q; kr[idx] = k; qs[d * 4 + i] = q * exp2f(lg2 * (float)(i + 1)); ks[d * 4 + i] = k * exp2f(lg2 * (float)(3 - i)); }
    __syncthreads();
#pragma unroll
    for (int pp = 0; pp < 2; ++pp) { const int pr = 2 * wave + pp, i = pr >> 2, j = pr & 3;
        const f32x4 a = *(const LAS f32x4*)(qr + i * 256 + 4 * lane), c = *(const LAS f32x4*)(kr + j * 256 + 4 * lane);
        float d = (a.x * c.x + a.y * c.y) + (a.z * c.z + a.w * c.w); d = wave_sum(d);
        if (lane == 0) scs[pr] = i >= j ? d * exp2f(lg2 * (float)(i - j)) : 0.f; }
    const int e = tid & 255, hf = tid >> 8;
    float v[4];
#pragma unroll
    for (int j = 0; j < 4; ++j) v[j] = bf2f(ZB[(size_t)(rowb + j) * 4096 + 2048 + h * 256 + e]);
    const float g4 = exp2f(lg2 * 4.0f);
    const float* S0 = sret + ((size_t)(s * 4 + h) * 256 + hf * 128) * 256 + e;
    float* S1 = rets + ((size_t)(s * 4 + h) * 256 + hf * 128) * 256 + e;
    float o[4] = {0.f, 0.f, 0.f, 0.f};
    for (int dd = 0; dd < 128; dd += 8) {
        float sv[8];
#pragma unroll
        for (int u = 0; u < 8; ++u) sv[u] = S0[(size_t)(dd + u) * 256];
#pragma unroll
        for (int u = 0; u < 8; ++u) { const int d = hf * 128 + dd + u;
            const f32x4 q4 = *(const LAS f32x4*)(qs + d * 4), k4 = *(const LAS f32x4*)(ks + d * 4);
            o[0] += q4.x * sv[u]; o[1] += q4.y * sv[u]; o[2] += q4.z * sv[u]; o[3] += q4.w * sv[u];
            S1[(size_t)(dd + u) * 256] = g4 * sv[u] + ((k4.x * v[0] + k4.y * v[1]) + (k4.z * v[2] + k4.w * v[3])); }
    }
#pragma unroll
    for (int i = 0; i < 4; ++i) part[(hf * 4 + i) * 256 + e] = o[i];
    __syncthreads();
    float oo[2], ss[2];
#pragma unroll
    for (int ii = 0; ii < 2; ++ii) { const int i = hf * 2 + ii;
        float x = part[i * 256 + e] + part[(4 + i) * 256 + e];
#pragma unroll
        for (int j = 0; j < 4; ++j) x += scs[i * 4 + j] * v[j];
        oo[ii] = x; ss[ii] = wave_sum(x * x); }
    if (lane == 0) { red[wave * 2] = ss[0]; red[wave * 2 + 1] = ss[1]; }
    __syncthreads();
#pragma unroll
    for (int ii = 0; ii < 2; ++ii) { const int i = hf * 2 + ii; const int w0 = hf * 4;
        const float tot = (red[w0 * 2 + ii] + red[(w0 + 1) * 2 + ii]) + (red[(w0 + 2) * 2 + ii] + red[(w0 + 3) * 2 + ii]);
        const float rs = 1.0f / sqrtf(tot * (1.0f / 256.0f) + 1e-6f);
        const float g = bf2f(ZB[(size_t)(rowb + i) * 4096 + 3072 + h * 256 + e]);
        OAB[(size_t)(rowb + i) * 2048 + 1024 + h * 256 + e] = (bf16)f2bf(oo[ii] * rs * (g / (1.0f + expf(-g)))); }
    __syncthreads();
}


#define IN_(k) (args.in[k])
#define x_prompt IN_(0)
#define x_sample IN_(1)
#define state_shift IN_(2)
#define state_rwkv IN_(3)
#define state_ret IN_(4)
#define meta IN_(5)
#define norm_mix IN_(6)
#define w_in IN_(7)
#define mu IN_(8)
#define w0 IN_(9)
#define w2 IN_(10)
#define a0 IN_(11)
#define a2 IN_(12)
#define g2 IN_(13)
#define k_k IN_(14)
#define k_a IN_(15)
#define r_k IN_(16)
#define ln_w IN_(17)
#define ln_b IN_(18)
#define w_out IN_(19)
#define norm_ffn IN_(20)
#define w_gate IN_(21)
#define w_up IN_(22)
#define w_down IN_(23)
#define norm_final IN_(24)
#define out (args.out)
#define CS ((float*)(ws + WS_CS))
#define BON ((float*)(ws + WS_BON))
#define WT_IN ((bf16*)(ws + WS_WIN))
#define WT_OUT ((bf16*)(ws + WS_WOUT))
#define WT_GU ((bf16*)(ws + WS_WGU))
#define WT_DN ((bf16*)(ws + WS_WDN))
#define XN ((bf16*)(ws + WS_XN))
#define OAB ((bf16*)(ws + WS_XN))
#define ZA ((float*)(ws + WS_ZA))
#define ZB ((bf16*)(ws + WS_ZB))
#define RKAB ((bf16*)(ws + WS_RKAB))
#define aW ((float*)(ws + WS_W))
#define aG ((float*)(ws + WS_G))
#define aO ((float*)(ws + WS_O))
#define ORET ((float*)(ws + WS_ORET))
#define H ((float*)(ws + WS_H))
#define ACT ((bf16*)(ws + WS_ACT))

typedef __attribute__((address_space(1))) unsigned gu32;
#define RLX_AGENT __ATOMIC_RELAXED, __HIP_MEMORY_SCOPE_AGENT
#define XB_TMO      128
#define XB_XCNT(j)  (256  + 64 * (j))
#define XB_XSUB(j)  (1280 + 64 * (j))
#define XB_XGEN(j)  (2304 + 64 * (j))
#define XB_TOP      3328
#define XB_TOPGEN   3392
#define XCD_BAR_WORDS 3456
#define XB_SPIN_CAP (1u << 18)

__device__ __forceinline__ unsigned xb_ld(unsigned* p)              { return __hip_atomic_load(p, __ATOMIC_RELAXED, __HIP_MEMORY_SCOPE_AGENT); }
__device__ __forceinline__ unsigned xb_add(unsigned* p, unsigned v) { return __hip_atomic_fetch_add(p, v, __ATOMIC_RELAXED, __HIP_MEMORY_SCOPE_AGENT); }
__device__ __forceinline__ unsigned xb_xcc_id() { return (unsigned)__builtin_amdgcn_s_getreg((3 << 11) | 20) & 0xFu; }
#define XB_SPIN(cond, bar) do { unsigned _sp = 0; while (cond) { __builtin_amdgcn_s_sleep(1); \
    if ((++_sp & 255u) == 0u) { if (xb_ld(&(bar)[XB_TMO])) break; if (_sp > XB_SPIN_CAP) { atomicAdd(&(bar)[XB_TMO], 1u); break; } } } } while (0)

struct XcdBarrier {
    unsigned* bar; unsigned x;
    volatile LAS unsigned* st;
};

__device__ __forceinline__ XcdBarrier xcd_barrier_post(unsigned* bar, volatile LAS unsigned* st) {
    XcdBarrier b; b.bar = bar; b.x = xb_xcc_id(); b.st = st;
    if (threadIdx.x == 0) (void)xb_add(&bar[XB_XCNT(b.x)], 1u);
    return b;
}
__device__ __forceinline__ void xcd_barrier_complete(unsigned* bar, unsigned x, unsigned& nloc, unsigned& nx) {
    const unsigned G = gridDim.x * gridDim.y * gridDim.z;
    unsigned sum, cnt, mine, sp = 0u;
    for (;;) {
        sum = 0u; cnt = 0u; mine = 0u;
#pragma unroll
        for (unsigned j = 0; j < 16; ++j) { const unsigned c = xb_ld(&bar[XB_XCNT(j)]); sum += c; cnt += (c > 0u) ? 1u : 0u; mine = (j == x) ? c : mine; }
        if (sum == G) break;
        __builtin_amdgcn_s_sleep(1);
        if ((++sp & 255u) == 0u) { if (xb_ld(&bar[XB_TMO])) break; if (sp > XB_SPIN_CAP) { atomicAdd(&bar[XB_TMO], 1u); break; } }
    }
    nloc = mine > 0u ? mine : 1u; nx = cnt > 0u ? cnt : 1u;
}

__device__ __forceinline__ void xcd_barrier(const XcdBarrier& b) {
    asm volatile("s_waitcnt vmcnt(0)" ::: "memory");
    __syncthreads();
    if (threadIdx.x == 0) {
        unsigned* bar = b.bar;
        __builtin_amdgcn_s_waitcnt(0);
        unsigned nloc = b.st[0], nx = b.st[1];
        if (nloc == 0u) { xcd_barrier_complete(bar, b.x, nloc, nx); b.st[0] = nloc; b.st[1] = nx; }
        const unsigned old = xb_add(&bar[XB_XSUB(b.x)], 1u);
        const unsigned gen = old / nloc;
        if (old + 1u == (gen + 1u) * nloc) {
            __builtin_amdgcn_fence(__ATOMIC_RELEASE, "agent");
            asm volatile("s_waitcnt vmcnt(0)" ::: "memory");
            const unsigned og = xb_add(&bar[XB_TOP], 1u);
            const unsigned tg = og / nx;
            if (og + 1u == (tg + 1u) * nx) xb_add(&bar[XB_TOPGEN], 1u);
            else XB_SPIN(xb_ld(&bar[XB_TOPGEN]) == tg, bar);
            __builtin_amdgcn_fence(__ATOMIC_ACQUIRE, "agent");
            xb_add(&bar[XB_XGEN(b.x)], 1u);
            asm volatile("s_waitcnt vmcnt(0)" ::: "memory");
        } else {
            XB_SPIN(xb_ld(&bar[XB_XGEN(b.x)]) == gen, bar);
            __builtin_amdgcn_fence(__ATOMIC_ACQUIRE, "agent");
            asm volatile("s_waitcnt vmcnt(0)" ::: "memory");
        }
    }
    __syncthreads();
}

constexpr int MISC_OFF = 147328;


__device__ __forceinline__ void rkab_unpack(const v4u& X, const v4u& Y, f32x4& r4, f32x4& k4, f32x4& a4, f32x4& b4) {
    r4 = (f32x4){bf2f(X.x & 0xffffu), bf2f(X.z & 0xffffu), bf2f(Y.x & 0xffffu), bf2f(Y.z & 0xffffu)};
    k4 = (f32x4){bf2f(X.x >> 16), bf2f(X.z >> 16), bf2f(Y.x >> 16), bf2f(Y.z >> 16)};
    a4 = (f32x4){bf2f(X.y & 0xffffu), bf2f(X.w & 0xffffu), bf2f(Y.y & 0xffffu), bf2f(Y.w & 0xffffu)};
    b4 = (f32x4){bf2f(X.y >> 16), bf2f(X.w >> 16), bf2f(Y.y >> 16), bf2f(Y.w >> 16)};
}
__device__ __forceinline__ void sample_scan_units(const unsigned char* ws, const float* p_rwkv, const float* p_shift, const float* p_mu, float* outp, int wu0, int wu1, int stride, int lane) {
    const int ri = lane >> 4, cq = lane & 15;
    for (int wub = wu0; wub < wu1; wub += 2 * stride) {
        f32x4 S[2]; float vmu[2], zprev[2]; int vcol[2], hh[2], ss[2], irow[2]; bool ok[2];
#pragma unroll
        for (int q = 0; q < 2; ++q) { const int wu = wub + q * stride; ok[q] = wu < wu1; const int wuc = ok[q] ? wu : wub;
            ss[q] = wuc >> 8; hh[q] = (wuc >> 4) & 15; irow[q] = (wuc & 15) * 4 + ri;
            S[q] = *(const f32x4*)(p_rwkv + ((size_t)((ss[q] * 16 + hh[q]) * 64 + irow[q])) * 64 + cq * 4);
            vcol[q] = 2048 + hh[q] * 64 + irow[q]; vmu[q] = p_mu[vcol[q]]; zprev[q] = p_shift[(size_t)ss[q] * RC + vcol[q]]; }
#pragma unroll
        for (int t = 0; t < 4; ++t) {
            f32x4 r4[2], w4[2], k4[2], a4[2], b4[2]; float z[2];
#pragma unroll
            for (int q = 0; q < 2; ++q) { const int row = MP + 4 * ss[q] + t; const size_t o = (size_t)row * 1024 + hh[q] * 64 + cq * 4;
                w4[q] = *(const f32x4*)(aW + o); { const v4u X_ = *(const v4u*)(RKAB + o * 4), Y_ = *(const v4u*)(RKAB + o * 4 + 8); rkab_unpack(X_, Y_, r4[q], k4[q], a4[q], b4[q]); }
                z[q] = ZA[(size_t)row * RC + vcol[q]]; }
#pragma unroll
            for (int q = 0; q < 2; ++q) { const int row = MP + 4 * ss[q] + t; const float vi = z[q] + vmu[q] * (zprev[q] - z[q]); zprev[q] = z[q];
                float ov; SCAN_STEP(S[q], r4[q], w4[q], k4[q], a4[q], b4[q], vi, ov);
                if (cq == 0 && ok[q]) aO[(size_t)row * 1024 + hh[q] * 64 + irow[q]] = ov; } }
#pragma unroll
        for (int q = 0; q < 2; ++q) if (ok[q]) *(f32x4*)(outp + OUT_RWS + ((size_t)((ss[q] * 16 + hh[q]) * 64 + irow[q])) * 64 + cq * 4) = S[q];
    }
}
constexpr int SS_SPLIT = 12288;


template <class Epi, int NSL>
__device__ __forceinline__ void gemm_fixup(const Epi& E, const pg8::Unit& u, const pg8::f32x4* p, int am, int wave, int lane) {
    const int ai = am >> 2, m = am & 3;
    pg8::f32x4 a[2][2];
#pragma unroll
    for (int bj = 0; bj < 2; ++bj)
#pragma unroll
        for (int n = 0; n < 2; ++n) { const int r = ((ai * 2 + bj) * 4 + m) * 2 + n; pg8::f32x4 v = p[(size_t)r * 512];
#pragma unroll
            for (int s = 1; s < NSL; ++s) v += p[((size_t)s * 32 + r) * 512];
            a[bj][n] = v; }
    E.row(a, ai, m, u, wave >> 2, wave & 3, lane & 15, lane >> 4);
}
#define GEMM_SPLIT(EPI_T, g_, Nn, E_, NSL_, KS_) do { \
    pg8::StaticOrder S_; S_.init(MPAD, (Nn), G, (int)blockIdx.x); const int nfull_ = (S_.nwg / G) * G, ntail_ = S_.nwg - nfull_; S_.limit = nfull_; \
    pg8::gemm_phase<EPI_T, pg8::StaticOrder, true, true>(L, g_, S_, E_); \
    if (ntail_ > 0) { \
        pg8::SplitOrder SS_{S_, nfull_, ntail_, (NSL_)}; pg8::Gemm gs_ = g_; gs_.K = (KS_); pg8::EpiPartial EP_{(float*)(ws + WS_PART)}; \
        pg8::gemm_phase<pg8::EpiPartial, pg8::SplitOrder, true, true>(L, gs_, SS_, EP_); \
        xcd_barrier(bar); \
        for (int it_ = blockIdx.x; it_ < ntail_ * 8; it_ += G) { const int j_ = it_ >> 3; pg8::Unit u_; S_.map(nfull_ + j_, u_); gemm_fixup<EPI_T, (NSL_)>(E_, u_, (const pg8::f32x4*)(ws + WS_PART) + (size_t)j_ * (NSL_) * 32 * 512 + tid, it_ & 7, wave, lane); } } } while (0)
__global__ void __launch_bounds__(512, 2) fwd(Args args) {
    extern __shared__ __attribute__((aligned(16))) unsigned char lds_raw[];
    LAS unsigned char* L = (LAS unsigned char*)lds_raw;
    const int tid = threadIdx.x, lane = tid & 63, wave = __builtin_amdgcn_readfirstlane(tid >> 6);
    const int G = gridDim.x;
#define gw ((int)blockIdx.x * 8 + wave)
#define NGW (G * 8)
#define gt ((int)blockIdx.x * 512 + tid)
#define NGT (G * 512)
    unsigned char* ws = args.ws;
    const int lo = args.ph_lo, hi = args.ph_hi;
    if (tid < 32) ((LAS unsigned*)(L + MISC_OFF))[tid] = 0u;
    __syncthreads();
    XcdBarrier bar = xcd_barrier_post((unsigned*)ws + 1024, (volatile LAS unsigned*)(L + MISC_OFF) + 8);
    if (hi > 1000) cg::this_grid().sync();
#ifndef PHMASK
#define PHMASK 0x3ff
#endif
#define IN(k) (((PHMASK >> (k)) & 1) && lo <= (k) && (k) < hi)
#define SEAM(k) do { if (IN(k) && IN((k) + 1)) { xcd_barrier(bar); } } while (0)

    if (IN(0)) {
        LAS float* scr = (LAS float*)(L + wave * 16384);
        constexpr int I_IN = 32 * 233, I_OUT = 32 * 64;
        for (int it = gw; it < I_IN + I_OUT; it += NGW) {
            if (it < I_IN) transpose_item(w_in, 2048, 7456, WT_IN, 1, scr, it, lane);
            else transpose_item(w_out, 2048, 2048, WT_OUT, 0, scr, it - I_IN, lane);
        }
        for (int i = gt; i < 224 * 256; i += NGT) *(v4u*)(WT_IN + (size_t)RC * 2048 + (size_t)i * 8) = (v4u){0u, 0u, 0u, 0u};
        for (int idx = gt; idx < 1024 * 288; idx += NGT) { const int c = idx / 288, i = idx - c * 288;
            const float v = i < 64 ? w2[(size_t)i * 1024 + c] : (i < 128 ? a2[(size_t)(i - 64) * 1024 + c] : g2[(size_t)(i - 128) * 1024 + c]);
            ((bf16*)(ws + WS_LT))[idx] = (bf16)f2bf(v); }
        for (int idx = gt; idx < NTP * 128; idx += NGT) {
            const int tp = idx >> 7, i = idx & 127;
            const double pos = tp < TP ? (double)tp : (double)(16384 + tp - TP);
            double invf = 1.0; for (int k = 0; k < i; ++k) invf *= 0.9300449458481391;
            const double ang = pos * invf;
            const double n = __builtin_rint(ang * 0.15915494309189535);
            double r = __builtin_fma(-n, 6.283185307179586, ang); r = __builtin_fma(-n, 2.4492935982947064e-16, r);
            const double r2 = r * r; double sn = r, cn = 1.0, ts = r, tc = 1.0;
            for (int k = 1; k <= 15; ++k) { tc *= -r2 / (double)((2 * k - 1) * (2 * k)); ts *= -r2 / (double)((2 * k) * (2 * k + 1)); cn += tc; sn += ts; }
            CS[(size_t)idx * 2] = (float)cn; CS[(size_t)idx * 2 + 1] = (float)sn;
        }
        for (int m = gw; m < MPAD; m += 2 * NGW) { const int m1 = m + NGW;
            if (m1 < MR) rms_rows2_bf16(pg8::xsrc_row(x_prompt, x_sample, meta, m), pg8::xsrc_row(x_prompt, x_sample, meta, m1), norm_mix, XN + (size_t)m * DM, XN + (size_t)m1 * DM, lane);
            else { if (m < MR) rms_row_bf16(pg8::xsrc_row(x_prompt, x_sample, meta, m), norm_mix, XN + (size_t)m * DM, lane); else zero_row_bf16(XN + (size_t)m * DM, lane);
                   if (m1 < MPAD) zero_row_bf16(XN + (size_t)m1 * DM, lane); }
        }
    }
    SEAM(0);
    if (IN(1)) {
        pg8::Gemm g{XN, WT_IN, MPAD, NIN, DM, DM};
        pg8::EpiIn E{ZA, ZB, CS};
        GEMM_SPLIT(pg8::EpiIn, g, NIN, E, 4, 512);
    }
    SEAM(1);
    if (IN(2)) {
        LAS unsigned char* X = L;
        const bf16* LT = (const bf16*)(ws + WS_LT);
        const int fr = lane & 15, fq = lane >> 4;
        if (args.sub & 1)
        for (int grp = blockIdx.x; grp < MR / 16; grp += G) {
            const int row0 = grp * 16;
            { float zv[9], zpv[9], muv[9]; int tidv = tid; asm volatile("" : "+v"(tidv));
#pragma unroll
            for (int it = 0; it < 9; ++it) { const int idx = tidv + 512 * it, t = idx / 288, i = idx - t * 288, row = row0 + t, col = 3072 + i;
                zv[it] = ZA[(size_t)row * RC + col]; zpv[it] = zprev_val(ZA, state_shift, row, col); muv[it] = mu[col]; }
#pragma unroll
            for (int it = 0; it < 9; ++it) { const int idx = tidv + 512 * it, t = idx / 288, i = idx - t * 288;
                const float zs = zv[it] + muv[it] * (zpv[it] - zv[it]);
                const float val = i < 64 ? ftanh(zs) : (i < 128 ? zs : fsig(zs));
                *(LAS unsigned short*)(X + t * 592 + i * 2) = (unsigned short)f2bf(val); } }
            __syncthreads();
            const int row = row0 + fr;
            const float* zrow = ZA + (size_t)row * RC; const float* pz;
            if (row < MP) pz = (row % TP) == 0 ? nullptr : zrow - RC;
            else { const int rr = row - MP; pz = (rr & 3) == 0 ? state_shift + (size_t)(rr >> 2) * RC : zrow - RC; }
#pragma unroll 1
            for (int hd = (args.sub & 64) ? 2 : 0; hd < 2; ++hd) { const int head = 2 * wave + hd;
                bf16x8 xf[9];
#pragma unroll
                for (int ks = 0; ks < 9; ++ks) xf[ks] = *(const LAS bf16x8*)(X + fr * 592 + (ks * 32 + 8 * fq) * 2);
                f32x4 aw[4], aa[4], ag[4];
#pragma unroll
                for (int t = 0; t < 4; ++t) { const bf16* wt = LT + (size_t)(head * 64 + 16 * t + fr) * 288 + 8 * fq;
                    aw[t] = (f32x4){0.f, 0.f, 0.f, 0.f}; aa[t] = aw[t]; ag[t] = aw[t];
#pragma unroll
                    for (int ks = 0; ks < 2; ++ks) aw[t] = __builtin_amdgcn_mfma_f32_16x16x32_bf16(*(const bf16x8*)(wt + ks * 32), xf[ks], aw[t], 0, 0, 0);
#pragma unroll
                    for (int ks = 0; ks < 2; ++ks) aa[t] = __builtin_amdgcn_mfma_f32_16x16x32_bf16(*(const bf16x8*)(wt + 64 + ks * 32), xf[2 + ks], aa[t], 0, 0, 0);
#pragma unroll
                    for (int ks = 0; ks < 5; ++ks) ag[t] = __builtin_amdgcn_mfma_f32_16x16x32_bf16(*(const bf16x8*)(wt + 128 + ks * 32), xf[4 + ks], ag[t], 0, 0, 0);
                    if (t == 1) asm volatile("" ::: "memory"); }
                if (args.sub & 32) {
#pragma unroll
                    for (int t = 0; t < 4; ++t) asm volatile("" :: "v"(aw[t]), "v"(aa[t]), "v"(ag[t]));
                    continue; }
                f32x4 kk4[4], av4[4], r4[4], dec4[4], k24[4]; float ssq = 0.f, bon = 0.f;
#pragma unroll
                for (int t = 0; t < 4; ++t) { const int c = head * 64 + 16 * t + 4 * fq;
                    const f32x4 zr = *(const f32x4*)(zrow + c), zk = *(const f32x4*)(zrow + 1024 + c);
                    f32x4 pr = (f32x4){0.f, 0.f, 0.f, 0.f}, pk = pr;
                    if (pz) { pr = *(const f32x4*)(pz + c); pk = *(const f32x4*)(pz + 1024 + c); }
                    const f32x4 r = zr + *(const f32x4*)(mu + c) * (pr - zr), k = zk + *(const f32x4*)(mu + 1024 + c) * (pk - zk);
                    const f32x4 w0v = *(const f32x4*)(w0 + c), a0v = *(const f32x4*)(a0 + c), kkv = *(const f32x4*)(k_k + c), kav = *(const f32x4*)(k_a + c), rkv = *(const f32x4*)(r_k + c);
                    r4[t] = r;
                    if (t == 2) {
#pragma unroll
                        for (int t2 = 0; t2 < 2; ++t2) { const size_t o2 = (size_t)row * 1024 + head * 64 + 16 * t2 + 4 * fq;
                            *(f32x4*)(aW + o2) = dec4[t2]; *(f32x4*)(aG + o2) = ag[t2]; } }
#pragma unroll
                    for (int q = 0; q < 4; ++q) { const float xx = -(w0v[q] + aw[t][q]);
                        const float sp = fmaxf(xx, 0.f) + __logf(1.0f + fexp(-fabsf(xx))); dec4[t][q] = fexp(-fexp(-sp - 0.5f));
                        av4[t][q] = fsig(a0v[q] + aa[t][q]); kk4[t][q] = k[q] * kkv[q]; k24[t][q] = k[q] * (1.0f + (av4[t][q] - 1.0f) * kav[q]);
                        ssq += kk4[t][q] * kk4[t][q]; bon += r[q] * k24[t][q] * rkv[q]; }
                    if (t == 1) asm volatile("" ::: "memory"); }
                ssq += __shfl_xor(ssq, 16); ssq += __shfl_xor(ssq, 32); bon += __shfl_xor(bon, 16); bon += __shfl_xor(bon, 32);
                const float inv = 1.0f / fmaxf(sqrtf(ssq), 1e-12f);
#pragma unroll
                for (int t = 0; t < 4; ++t) { const size_t o = (size_t)row * 1024 + head * 64 + 16 * t + 4 * fq;
                    const f32x4 kk = kk4[t] * inv, na = -kk, nb = kk * av4[t];
                    v4u X_, Y_; X_.x = pk2(r4[t].x, k24[t].x); X_.y = pk2(na.x, nb.x); X_.z = pk2(r4[t].y, k24[t].y); X_.w = pk2(na.y, nb.y);
                    Y_.x = pk2(r4[t].z, k24[t].z); Y_.y = pk2(na.z, nb.z); Y_.z = pk2(r4[t].w, k24[t].w); Y_.w = pk2(na.w, nb.w);
                    *(v4u*)(RKAB + o * 4) = X_; *(v4u*)(RKAB + o * 4 + 8) = Y_;
                    if (t >= 2) { *(f32x4*)(aW + o) = dec4[t]; *(f32x4*)(aG + o) = ag[t]; } }
                if (fq == 0) BON[(size_t)row * 16 + head] = bon;
            }
            __syncthreads();
        }
        { const int ngrp = MR / 16, rounds = (ngrp + G - 1) / G, nheavy = ngrp - (rounds - 1) * G;
          const int nlightb = G - nheavy;
          if (nlightb > 0 && (int)blockIdx.x >= nheavy) {
            LAS float* scr = (LAS float*)(L + wave * 16384);
            constexpr int I_G = 32 * 176, I_D = 88 * 64;
            for (int it = ((int)blockIdx.x - nheavy) * 8 + wave; it < 2 * I_G + I_D; it += nlightb * 8) {
                if (it < I_G) transpose_item(w_gate, 2048, DFF, WT_GU, 2, scr, it, lane);
                else if (it < 2 * I_G) transpose_item(w_up, 2048, DFF, WT_GU, 3, scr, it - I_G, lane);
                else transpose_item(w_down, DFF, 2048, WT_DN, 0, scr, it - 2 * I_G, lane);
            } } }
    }
    SEAM(2);
    if (IN(3)) {
        const int GH = G >> 1;
        if ((int)blockIdx.x >= GH) {
            const int bx = blockIdx.x - GH, GR = G - GH;
            if (args.sub & 2)
            for (int u = bx; u < 128; u += GR) ret_prompt_unit(L, ZB, ORET, out + OUT_RTP, u, tid);
            if (args.sub & 4)
            for (int u = bx; u < 512; u += GR) ret_sample_unit(L, ZB, state_ret, out + OUT_RTS, OAB, u, tid);
            if (args.sub & 16) sample_scan_units(ws, state_rwkv, state_shift, mu, out, SS_SPLIT + bx * 8 + wave, NS * 16 * 16, GR * 8, lane);
        } else {
        LAS float* buf = (LAS float*)L;
        LAS float* vbuf = buf + 2 * 16 * 320;
        const int ri = lane >> 4, cq = lane & 15;
        if (args.sub & 8)
        for (int u = blockIdx.x; u < 128; u += GH) {
            const int b = u >> 5, h = (u >> 1) & 15, hf = u & 1;
            const int rowb = b * TP;
            f32x4 S = (f32x4){0.f, 0.f, 0.f, 0.f};
            const int irow = hf * 32 + wave * 4 + ri;
            f32x4 prew[2]; v4u prex[2], prey[2]; float prevz[2], prevp[2];
            const bool l_last = tid < 256;
            const int l_st = (tid >> 4) & 15, l_c4 = tid & 15, l_off = l_st * 1024 + h * 64 + l_c4 * 4, l_lds = l_st * 320 + l_c4 * 4;
            const int v_st = tid >> 5, v_rr = tid & 31, v_col = 2048 + h * 64 + hf * 32 + v_rr;
            const float v_mu = mu[v_col];
            float keep = 0.f;
#define SCAN_LOAD(c, s_) do { const size_t rb_ = (size_t)(rowb + (c) * 16); \
            if (l_last) { prew[s_] = *(const f32x4*)(aW + rb_ * 1024 + l_off); prex[s_] = *(const v4u*)(RKAB + (rb_ * 1024 + l_off) * 4); prey[s_] = *(const v4u*)(RKAB + (rb_ * 1024 + l_off) * 4 + 8); } \
            { const int p_ = (c) * 16 + v_st; prevz[s_] = ZA[(size_t)(rowb + p_) * RC + v_col]; prevp[s_] = p_ == 0 ? 0.f : ZA[(size_t)(rowb + p_ - 1) * RC + v_col]; } } while (0)
#define SCAN_STORE(bb, s_) do { \
            if (l_last) { f32x4 r_, k_, a_, b_; rkab_unpack(prex[s_], prey[s_], r_, k_, a_, b_); LAS float* d_ = buf + (bb) * 5120 + l_lds; \
                *(LAS f32x4*)d_ = r_; *(LAS f32x4*)(d_ + 64) = prew[s_]; *(LAS f32x4*)(d_ + 128) = k_; *(LAS f32x4*)(d_ + 192) = a_; *(LAS f32x4*)(d_ + 256) = b_; } \
            vbuf[(bb) * 512 + v_st * 32 + v_rr] = prevz[s_] + v_mu * (prevp[s_] - prevz[s_]); } while (0)
#define SCAN_ITER(k) do { const int c = c0 + (k); if (c < 129) { \
                { const LAS float* bb = buf + ((k) & 1) * 5120; const LAS float* vb = vbuf + ((k) & 1) * 512; \
                    _Pragma("unroll 4") for (int st = 0; st < 16; ++st) { \
                        const f32x4 r4 = *(const LAS f32x4*)(bb + st * 320 + 0 * 64 + cq * 4), w4 = *(const LAS f32x4*)(bb + st * 320 + 1 * 64 + cq * 4), k4 = *(const LAS f32x4*)(bb + st * 320 + 2 * 64 + cq * 4); \
                        const f32x4 a4 = *(const LAS f32x4*)(bb + st * 320 + 3 * 64 + cq * 4), b4 = *(const LAS f32x4*)(bb + st * 320 + 4 * 64 + cq * 4); \
                        const float vi = vb[st * 32 + wave * 4 + ri]; \
                        float ov; SCAN_STEP(S, r4, w4, k4, a4, b4, vi, ov); \
                        keep = cq == st ? ov : keep; \
                    } } \
                if (c + 1 < 129) SCAN_STORE(((k) + 1) & 1, ((k) + 1) & 1); \
                if (c + 3 < 129) SCAN_LOAD(c + 3, ((k) + 1) & 1); \
                aO[(size_t)(rowb + c * 16 + cq) * 1024 + h * 64 + irow] = keep; \
                __syncthreads(); } } while (0)
            SCAN_LOAD(0, 0); SCAN_LOAD(1, 1); SCAN_STORE(0, 0); SCAN_LOAD(2, 0);
            __syncthreads();
            for (int c0 = 0; c0 < 129; c0 += 2) { SCAN_ITER(0); SCAN_ITER(1); }
            *(f32x4*)(out + OUT_RWP + ((size_t)((b * 16 + h) * 64 + irow)) * 64 + cq * 4) = S;
            __syncthreads();
        }
#undef SCAN_LOAD
#undef SCAN_STORE
#undef SCAN_ITER
        if (args.sub & 16) sample_scan_units(ws, state_rwkv, state_shift, mu, out, gw, SS_SPLIT, GH * 8, lane);
        }
    }
    SEAM(3);
    if (IN(4)) {
        for (int wu = gw; wu < MR * 4; wu += NGW) {
            const int row = wu >> 2, c = (wu & 3) * 256 + 4 * lane, head = c >> 6;
            const f32x4 o = *(const f32x4*)(aO + (size_t)row * 1024 + c);
            const float* zr = ZA + (size_t)row * RC + 2048 + c; const f32x4 z = *(const f32x4*)zr; f32x4 zp = (f32x4){0.f, 0.f, 0.f, 0.f};
            if (row < MP) { if ((row % TP) != 0) zp = *(const f32x4*)(zr - RC); }
            else { const int rr = row - MP; zp = (rr & 3) == 0 ? *(const f32x4*)(state_shift + (size_t)(rr >> 2) * RC + 2048 + c) : *(const f32x4*)(zr - RC); }
            const f32x4 muv = *(const f32x4*)(mu + 2048 + c), lw = *(const f32x4*)(ln_w + c), lb = *(const f32x4*)(ln_b + c), g = *(const f32x4*)(aG + (size_t)row * 1024 + c);
            const float bon = BON[(size_t)row * 16 + head];
            const float mean = rowsum16((o.x + o.y) + (o.z + o.w)) * (1.0f / 64.0f);
            const f32x4 d = o - mean;
            const float var = rowsum16((d.x * d.x + d.y * d.y) + (d.z * d.z + d.w * d.w)) * (1.0f / 64.0f);
            const float rs = 1.0f / sqrtf(var + 64e-5f);
            const f32x4 v = z + muv * (zp - z);
            const f32x4 res = (d * rs * lw + lb + v * bon) * g;
            v2u w; w.x = pk2(res.x, res.y); w.y = pk2(res.z, res.w);
            *(v2u*)(OAB + (size_t)row * 2048 + c) = w;
        }
        for (int wu = gw; wu < MP * 4; wu += NGW) {
            const int row = wu >> 2, h = wu & 3, c = h * 256 + 4 * lane;
            const f32x4 o = *(const f32x4*)(ORET + (size_t)row * 1024 + c);
            const float ss = wave_sum((o.x * o.x + o.y * o.y) + (o.z * o.z + o.w * o.w));
            const float rs = 1.0f / sqrtf(ss * (1.0f / 256.0f) + 1e-6f);
            const v2u gb = *(const v2u*)(ZB + (size_t)row * 4096 + 3072 + c);
            const float g0 = bf2f(gb.x & 0xffffu), g1 = bf2f(gb.x >> 16), g2_ = bf2f(gb.y & 0xffffu), g3 = bf2f(gb.y >> 16);
            v2u w; w.x = pk2(o.x * rs * (g0 / (1.0f + expf(-g0))), o.y * rs * (g1 / (1.0f + expf(-g1)))); w.y = pk2(o.z * rs * (g2_ / (1.0f + expf(-g2_))), o.w * rs * (g3 / (1.0f + expf(-g3))));
            *(v2u*)(OAB + (size_t)row * 2048 + 1024 + c) = w;
        }
        for (int i = gt; i < (NB + NS) * RC; i += NGT) { const int sq = i / RC, col = i - sq * RC;
            if (sq < NB) out[OUT_SHP + (size_t)sq * RC + col] = ZA[(size_t)(sq * TP + TP - 1) * RC + col];
            else out[OUT_SHS + (size_t)(sq - NB) * RC + col] = ZA[(size_t)(MP + 4 * (sq - NB) + 3) * RC + col]; }
    }
    SEAM(4);
    if (IN(5)) {
        pg8::Gemm g{OAB, WT_OUT, MPAD, DM, DM, DM};
        pg8::EpiOut E{H, x_prompt, x_sample, meta};
        GEMM_SPLIT(pg8::EpiOut, g, DM, E, 4, 512);
    }
    SEAM(5);
    if (IN(6)) {
        for (int m = gw; m < MPAD; m += 2 * NGW) { const int m1 = m + NGW;
            if (m1 < MR) rms_rows2_bf16(H + (size_t)m * DM, H + (size_t)m1 * DM, norm_ffn, XN + (size_t)m * DM, XN + (size_t)m1 * DM, lane);
            else { if (m < MR) rms_row_bf16(H + (size_t)m * DM, norm_ffn, XN + (size_t)m * DM, lane); else zero_row_bf16(XN + (size_t)m * DM, lane);
                   if (m1 < MPAD) zero_row_bf16(XN + (size_t)m1 * DM, lane); }
        }
    }
    SEAM(6);
    if (IN(7)) {
        pg8::Gemm g{XN, WT_GU, MPAD, 2 * DFF, DM, DM};
        pg8::EpiGateUp E{ACT};
        GEMM_SPLIT(pg8::EpiGateUp, g, 2 * DFF, E, 4, 512);
    }
    SEAM(7);
    if (IN(8)) {
        pg8::Gemm g{ACT, WT_DN, MPAD, DM, DFF, DFF};
        pg8::EpiDown E{H};
        GEMM_SPLIT(pg8::EpiDown, g, DM, E, 4, 1408);
    }
    SEAM(8);
    if (IN(9)) {
        for (int m = gw; m < MR; m += NGW) {
            float* dst;
            if (m < MP) { const int b = m / TP, p = m - b * TP; if (p < 16) continue; dst = out + OUT_YP + ((size_t)b * SEQ + (p - 16)) * DM; }
            else dst = out + OUT_YS + (size_t)(m - MP) * DM;
            const float* xr = H + (size_t)m * DM;
            f32x4 v[8]; float s = 0.f;
#pragma unroll
            for (int j = 0; j < 8; ++j) { v[j] = *(const f32x4*)(xr + 4 * lane + 256 * j); s += (v[j].x * v[j].x + v[j].y * v[j].y) + (v[j].z * v[j].z + v[j].w * v[j].w); }
            const float rs = 1.0f / sqrtf(wave_sum(s) * (1.0f / 2048.0f) + 1e-6f);
#pragma unroll
            for (int j = 0; j < 8; ++j) { const f32x4 g = *(const f32x4*)(norm_final + 4 * lane + 256 * j); *(f32x4*)(dst + 4 * lane + 256 * j) = v[j] * rs * g; }
        }
    }
#undef IN
#undef SEAM
#undef gw
#undef NGW
#undef gt
#undef NGT
}

#undef x_prompt
#undef x_sample
#undef state_shift
#undef state_rwkv
#undef state_ret
#undef meta
#undef norm_mix
#undef w_in
#undef mu
#undef w0
#undef w2
#undef a0
#undef a2
#undef g2
#undef k_k
#undef k_a
#undef r_k
#undef ln_w
#undef ln_b
#undef w_out
#undef norm_ffn
#undef w_gate
#undef w_up
#undef w_down
#undef norm_final
#undef out
#undef CS
#undef BON
#undef WT_IN
#undef WT_OUT
#undef WT_GU
#undef WT_DN
#undef XN
#undef OAB
#undef ZA
#undef ZB
#undef RKAB
#undef aW
#undef aG
#undef aO
#undef ORET
#undef H
#undef ACT
#undef IN_
#ifndef MK_MULTI
#define MK_MULTI 0
#endif
extern "C" void kernel_launch(void* const* d_in, const int* in_sizes, int n_in, void* d_out, int out_size, void* d_ws, size_t ws_size, hipStream_t stream) {
    static int grid = 0;
    if (grid == 0) {
        int dev = 0, cus = 0, per_cu = 0;
        (void)hipGetDevice(&dev);
        (void)hipDeviceGetAttribute(&cus, hipDeviceAttributeMultiprocessorCount, dev);
        (void)hipFuncSetAttribute((const void*)fwd, hipFuncAttributeMaxDynamicSharedMemorySize, LDS_BYTES);
        if (hipOccupancyMaxActiveBlocksPerMultiprocessor(&per_cu, (const void*)fwd, 512, LDS_BYTES) != hipSuccess || per_cu < 1) per_cu = 1;
        (void)hipGetLastError();
        if (per_cu > 1) per_cu = 1;
        grid = cus > 0 ? cus * per_cu : 256;
        if (ws_size < WS_END) fprintf(stderr, "kernel_launch: workspace too small: %zu < %zu\n", ws_size, (size_t)WS_END);
    }
    (void)hipMemsetAsync(d_ws, 0, 65536, stream);
    Args a{};
    for (int i = 0; i < 25; ++i) a.in[i] = (const float*)d_in[i];
    a.out = (float*)d_out; a.ws = (unsigned char*)d_ws; a.sub = 31;
#if MK_MULTI
#ifndef REPEAT_MASK
#define REPEAT_MASK 0
#endif
#ifndef REPEAT_SUB
#define REPEAT_SUB 7
#endif
    for (int ph = 0; ph < NPH; ++ph) for (int rep = 0; rep < 1 + ((REPEAT_MASK >> ph) & 1); ++rep) { a.ph_lo = ph; a.ph_hi = ph + 1; a.sub = rep ? REPEAT_SUB : 31; (void)hipMemsetAsync(d_ws, 0, 65536, stream); hipLaunchKernelGGL(fwd, dim3(grid), dim3(512), LDS_BYTES, stream, a); }
#else
    a.ph_lo = 0; a.ph_hi = NPH;
    void* kargs[] = {&a};
    hipError_t e = hipLaunchCooperativeKernel((const void*)fwd, dim3(grid), dim3(512), kargs, LDS_BYTES, stream);
    if (e != hipSuccess) fprintf(stderr, "cooperative launch failed: %s (grid %d)\n", hipGetErrorString(e), grid);
#endif
}
```

```cpp
#define MK_MULTI 0
#include <hip/hip_runtime.h>
#include <hip/hip_cooperative_groups.h>
#include <cstdio>
#include <cstdint>
namespace cg = cooperative_groups;
namespace pg8 {
#define PG8_LAS __attribute__((address_space(3)))
typedef unsigned short bf16_t;
typedef short bf16x8 __attribute__((ext_vector_type(8)));
typedef float f32x4 __attribute__((ext_vector_type(4)));
typedef unsigned u32x4 __attribute__((ext_vector_type(4)));
constexpr int BM = 256, BK = 64, HALF = 128, HTB = HALF * BK * 2  , STAGE_BYTES = 8 * HTB, NXCD = 8, WGM = 4;

__host__ __device__ __forceinline__ int lds_byte(int r, int c) { const int st = (r >> 4) * 2 + (c >> 5), rr = r & 15, cc = c & 31, ob = rr * 64 + cc * 2; return st * 1024 + (ob ^ (((ob >> 9) & 1) << 5)); }
__host__ __device__ __forceinline__ void stage_rc(int b, int& R, int& C) { const int st = b / 1024, sb = b % 1024, swz = sb ^ (((sb >> 9) & 1) << 5); R = (st >> 1) * 16 + swz / 64; C = (st & 1) * 32 + (swz % 64) / 2; }
__host__ __device__ __forceinline__ int perm32(int rho) { const int n = rho >> 4, i = rho & 15; return 8 * (i >> 2) + 4 * n + (i & 3); }

struct Unit { int pm, pn, ks, aux; };
struct Gemm { const bf16_t* A; const bf16_t* Bt; int M, N, K, ld; };

struct StaticOrder {
    int nM, nN, nwg, G, c, limit;
    __host__ __device__ void init(int M, int N, int G_, int c_) { nM = M / BM; nN = N / BM; nwg = nM * nN; G = G_; c = c_; limit = nwg; }
    __host__ __device__ __forceinline__ bool next(int i, Unit& u) const {
        const long L = (long)i * G + c; if (L >= limit) return false;
        return map((int)L, u);
    }
    __host__ __device__ __forceinline__ bool map(int L, Unit& u) const {
        int wgid = L; u.ks = 0; u.aux = 0; { const int q = nwg / NXCD, r = nwg % NXCD, xcd = wgid % NXCD, off = wgid / NXCD; wgid = (xcd < r ? xcd * (q + 1) : r * (q + 1) + (xcd - r) * q) + off; }
        const int nig = WGM * nN, gid = wgid / nig, fm = gid * WGM, gsz = (nM - fm) < WGM ? (nM - fm) : WGM;
        u.pm = fm + ((wgid % nig) % gsz); u.pn = (wgid % nig) / gsz; return true;
    }
    __device__ __forceinline__ void a_ready(const Unit&) const {}
    __device__ __forceinline__ void done(const Unit&) const {}
};


__device__ __forceinline__ unsigned cvt_pk_bf16(float lo, float hi) { unsigned r; asm volatile("v_cvt_pk_bf16_f32 %0, %1, %2" : "=v"(r) : "v"(lo), "v"(hi)); return r; }

constexpr int E_MP = 8256, E_MR = 8768, E_TP = 2064, E_RC = 3360;

#define EPI_WALK() \
    __device__ __forceinline__ void operator()(const f32x4 (&acc)[2][2][4][2], const Unit& u, int wr, int wc, int fr, int fq) const { \
        _Pragma("unroll") for (int ai = 0; ai < 2; ++ai) _Pragma("unroll") for (int m = 0; m < 4; ++m) { \
            f32x4 a[2][2]; a[0][0] = acc[ai][0][m][0]; a[0][1] = acc[ai][0][m][1]; a[1][0] = acc[ai][1][m][0]; a[1][1] = acc[ai][1][m][1]; row(a, ai, m, u, wr, wc, fr, fq); } }

struct EpiIn {
    static constexpr bool PERM = true, AFTER_DRAIN = false;
    float* ZA; bf16_t* ZB; const float* CS;
    __device__ __forceinline__ void row(const f32x4 (&a)[2][2], int ai, int m, const Unit& u, int wr, int wc, int fr, int fq) const {
        const int row = u.pm * BM + wr * 64 + fr + ai * HALF + m * 16;
        if (u.pn < 14) {
#pragma unroll
            for (int bj = 0; bj < 2; ++bj) { const int col = u.pn * BM + bj * HALF + wc * 32 + 8 * fq;
                if (col < E_RC) { float* p = ZA + (size_t)row * E_RC + col; *(f32x4*)p = a[bj][0]; *(f32x4*)(p + 4) = a[bj][1]; } }
        } else {
            const int ct = (u.pn - 14) * BM;
            const int tp = row < E_MP ? row % E_TP : (row < E_MR ? E_TP + ((row - E_MP) & 3) : 0);
#pragma unroll
            for (int bj = 0; bj < 2; ++bj) { const int c = ct + bj * HALF + wc * 32 + 8 * fq;
                f32x4 v0 = a[bj][0], v1 = a[bj][1];
                if (c < 2048) {
                    const float* cs = CS + ((size_t)tp * 128 + ((c & 255) >> 1)) * 2;
                    const f32x4 t0 = *(const f32x4*)cs, t1 = *(const f32x4*)(cs + 4);
                    const float sc = c >= 1024 ? 0.0625f : 1.0f;
                    f32x4 w0, w1;
                    w0[0] = (v0[0] * t0[0] - v0[1] * t0[1]) * sc; w0[1] = (v0[0] * t0[1] + v0[1] * t0[0]) * sc;
                    w0[2] = (v0[2] * t0[2] - v0[3] * t0[3]) * sc; w0[3] = (v0[2] * t0[3] + v0[3] * t0[2]) * sc;
                    w1[0] = (v1[0] * t1[0] - v1[1] * t1[1]) * sc; w1[1] = (v1[0] * t1[1] + v1[1] * t1[0]) * sc;
                    w1[2] = (v1[2] * t1[2] - v1[3] * t1[3]) * sc; w1[3] = (v1[2] * t1[3] + v1[3] * t1[2]) * sc;
                    v0 = w0; v1 = w1;
                }
                u32x4 w; w.x = cvt_pk_bf16(v0[0], v0[1]); w.y = cvt_pk_bf16(v0[2], v0[3]); w.z = cvt_pk_bf16(v1[0], v1[1]); w.w = cvt_pk_bf16(v1[2], v1[3]);
                *(u32x4*)(ZB + (size_t)row * 4096 + c) = w; }
        }
    }
    EPI_WALK()
};

__device__ __forceinline__ const float* xsrc_row(const float* xp, const float* xs, const float* meta, int row) {
    if (row < E_MP) { const int b = row / E_TP, p = row - b * E_TP; return p < 16 ? meta + (size_t)p * 2048 : xp + ((size_t)b * 2048 + (p - 16)) * 2048; }
    if (row < E_MR) return xs + (size_t)(row - E_MP) * 2048;
    return nullptr;
}

struct EpiOut {
    static constexpr bool PERM = true, AFTER_DRAIN = false;
    float* H; const float* xp; const float* xs; const float* meta;
    __device__ __forceinline__ void row(const f32x4 (&a)[2][2], int ai, int m, const Unit& u, int wr, int wc, int fr, int fq) const {
        const int row = u.pm * BM + wr * 64 + fr + ai * HALF + m * 16; const float* xr = xsrc_row(xp, xs, meta, row);
#pragma unroll
        for (int bj = 0; bj < 2; ++bj) { const int col = u.pn * BM + bj * HALF + wc * 32 + 8 * fq;
            f32x4 v0 = a[bj][0], v1 = a[bj][1];
            if (xr) { v0 += *(const f32x4*)(xr + col); v1 += *(const f32x4*)(xr + col + 4); }
            float* p = H + (size_t)row * 2048 + col; *(f32x4*)p = v0; *(f32x4*)(p + 4) = v1; }
    }
    EPI_WALK()
};

__device__ __forceinline__ float silu_f(float x) { return x / (1.0f + __expf(-x)); }

struct EpiGateUp {
    static constexpr bool PERM = true, AFTER_DRAIN = false;
    bf16_t* ACT;
    __device__ __forceinline__ void row(const f32x4 (&a)[2][2], int ai, int m, const Unit& u, int wr, int wc, int fr, int fq) const {
        const int row = u.pm * BM + wr * 64 + fr + ai * HALF + m * 16; const int col = u.pn * HALF + wc * 32 + 8 * fq;
        const f32x4 g0 = a[0][0], g1 = a[0][1], u0 = a[1][0], u1 = a[1][1];
        u32x4 w;
        w.x = cvt_pk_bf16(silu_f(g0[0]) * u0[0], silu_f(g0[1]) * u0[1]); w.y = cvt_pk_bf16(silu_f(g0[2]) * u0[2], silu_f(g0[3]) * u0[3]);
        w.z = cvt_pk_bf16(silu_f(g1[0]) * u1[0], silu_f(g1[1]) * u1[1]); w.w = cvt_pk_bf16(silu_f(g1[2]) * u1[2], silu_f(g1[3]) * u1[3]);
        *(u32x4*)(ACT + (size_t)row * 5632 + col) = w;
    }
    EPI_WALK()
};

struct EpiDown {
    static constexpr bool PERM = true, AFTER_DRAIN = false;
    float* H;
    __device__ __forceinline__ void row(const f32x4 (&a)[2][2], int ai, int m, const Unit& u, int wr, int wc, int fr, int fq) const {
        const int row = u.pm * BM + wr * 64 + fr + ai * HALF + m * 16;
#pragma unroll
        for (int bj = 0; bj < 2; ++bj) { const int col = u.pn * BM + bj * HALF + wc * 32 + 8 * fq;
            float* p = H + (size_t)row * 2048 + col;
            const f32x4 v0 = *(const f32x4*)p + a[bj][0], v1 = *(const f32x4*)(p + 4) + a[bj][1];
            *(f32x4*)p = v0; *(f32x4*)(p + 4) = v1; }
    }
    EPI_WALK()
};

struct SplitOrder {
    StaticOrder so; int base, ntail, nsl;
    __device__ __forceinline__ bool next(int i, Unit& u) const { const int v = i * so.G + so.c; if (v >= ntail * nsl) return false; so.map(base + v / nsl, u); u.ks = v % nsl; u.aux = v; return true; }
    __device__ __forceinline__ void a_ready(const Unit&) const {}
    __device__ __forceinline__ void done(const Unit&) const {}
};
struct EpiPartial {
    static constexpr bool PERM = true, AFTER_DRAIN = false;
    float* P;
    __device__ __forceinline__ void operator()(const f32x4 (&acc)[2][2][4][2], const Unit& u, int wr, int wc, int fr, int fq) const {
        f32x4* p = (f32x4*)P + (size_t)u.aux * 32 * 512 + threadIdx.x;
#pragma unroll
        for (int ai = 0; ai < 2; ++ai)
#pragma unroll
            for (int bj = 0; bj < 2; ++bj)
#pragma unroll
                for (int m = 0; m < 4; ++m)
#pragma unroll
                    for (int n = 0; n < 2; ++n) p[(size_t)((((ai * 2 + bj) * 4 + m) * 2 + n)) * 512] = acc[ai][bj][m][n];
    }
};
template <class Epi, class Sched, bool ALIGN_EPI = false, bool SP2 = false>
__device__ __forceinline__ void gemm_phase(PG8_LAS unsigned char* lds, const Gemm g, const Sched& S, const Epi& E) {
    const int tid = threadIdx.x, wid = __builtin_amdgcn_readfirstlane(tid >> 6), lane = tid & 63, wr = wid >> 2, wc = wid & 3, fr = lane & 15, fq = lane >> 4;
    const int K = g.K, nt = K / BK, KL = g.ld;
    unsigned voffA[2], voffB[2];
#pragma unroll
    for (int i = 0; i < 2; ++i) { int R, C; stage_rc(tid * 16 + i * 8192, R, C); const int Rb = Epi::PERM ? ((R & ~31) + perm32(R & 31)) : R;
        voffA[i] = (unsigned)(R * KL + C) * 2u; voffB[i] = (unsigned)(Rb * KL + C) * 2u; }
    const size_t kstep = (size_t)(BK * 2);
    const size_t hstep = (size_t)HALF * KL * 2;
    const size_t tstep = 2 * hstep;
    const unsigned ldsw = (unsigned)wid * 1024u;
    const int aoff = lds_byte(wr * 64 + fr, fq * 8), boff = lds_byte(wc * 32 + fr, fq * 8);
#define PG8_SA(b, h) (((b) * 2 + (h)) * HTB)
#define PG8_SB(b, h) ((4 + (b) * 2 + (h)) * HTB)
#define PG8_STAGE(bufoff, gbase, voff) do { _Pragma("unroll") for (int _i = 0; _i < 2; ++_i) \
        __builtin_amdgcn_global_load_lds((const unsigned*)((const char*)(gbase) + (voff)[_i]), (PG8_LAS unsigned*)(lds + (bufoff) + ldsw + _i * 8192), 16, 0, 0); } while (0)
#define PG8_LDA(dst, b, h) do { _Pragma("unroll") for (int m = 0; m < 4; ++m) _Pragma("unroll") for (int k = 0; k < 2; ++k) dst[m][k] = *(const PG8_LAS bf16x8*)(lds + PG8_SA(b, h) + aoff + m * 2048 + k * 1024); } while (0)
#define PG8_LDB(dst, b, h) do { _Pragma("unroll") for (int n = 0; n < 2; ++n) _Pragma("unroll") for (int k = 0; k < 2; ++k) dst[n][k] = *(const PG8_LAS bf16x8*)(lds + PG8_SB(b, h) + boff + n * 2048 + k * 1024); } while (0)
#define PG8_MMA(ai, bj, At, Bt) do { __builtin_amdgcn_s_setprio(1); _Pragma("unroll") for (int m = 0; m < 4; ++m) _Pragma("unroll") for (int n = 0; n < 2; ++n) _Pragma("unroll") for (int k = 0; k < 2; ++k) \
        acc[ai][bj][m][n] = __builtin_amdgcn_mfma_f32_16x16x32_bf16(Bt[n][k], At[m][k], acc[ai][bj][m][n], 0, 0, 0); __builtin_amdgcn_s_setprio(0); } while (0)
#define PG8_WAIT_V(n) asm volatile("s_waitcnt vmcnt(" #n ")" ::: "memory")
#define PG8_WAIT_L(n) asm volatile("s_waitcnt lgkmcnt(" #n ")" ::: "memory")
#define PG8_BAR __builtin_amdgcn_s_barrier()
#define PG8_SCHED __builtin_amdgcn_sched_barrier(0)
    Unit cur, nxt; int ui = 0;
    if (!S.next(0, cur)) return;
    f32x4 acc[2][2][4][2];
#pragma unroll
    for (int a = 0; a < 2; ++a)
#pragma unroll
        for (int b = 0; b < 2; ++b)
#pragma unroll
            for (int m = 0; m < 4; ++m)
#pragma unroll
                for (int n = 0; n < 2; ++n) acc[a][b][m][n] = (f32x4){0.f, 0.f, 0.f, 0.f};
    bf16x8 At[4][2], B0[2][2], B1[2][2];
    const char* cA = (const char*)g.A + (size_t)cur.pm * tstep + (size_t)cur.ks * K * 2; const char* cB = (const char*)g.Bt + (size_t)cur.pn * tstep + (size_t)cur.ks * K * 2;
    S.a_ready(cur);
    if constexpr (SP2) {
        PG8_STAGE(PG8_SB(0, 0), cB, voffB); PG8_STAGE(PG8_SB(0, 1), cB + hstep, voffB); PG8_STAGE(PG8_SA(0, 0), cA, voffA); PG8_STAGE(PG8_SA(0, 1), cA + hstep, voffA);
        if (wr == 1) PG8_BAR;
        PG8_WAIT_V(2); PG8_BAR;
        PG8_STAGE(PG8_SB(1, 0), cB + kstep, voffB); PG8_STAGE(PG8_SA(1, 0), cA + kstep, voffA); PG8_STAGE(PG8_SB(1, 1), cB + hstep + kstep, voffB);
        PG8_WAIT_V(6); PG8_BAR;
    } else {
        PG8_STAGE(PG8_SB(0, 0), cB, voffB); PG8_STAGE(PG8_SA(0, 0), cA, voffA); PG8_STAGE(PG8_SB(0, 1), cB + hstep, voffB); PG8_STAGE(PG8_SA(0, 1), cA + hstep, voffA);
        if (wr == 1) PG8_BAR;
        PG8_WAIT_V(4); PG8_BAR;
        PG8_STAGE(PG8_SB(1, 0), cB + kstep, voffB); PG8_STAGE(PG8_SA(1, 0), cA + kstep, voffA); PG8_STAGE(PG8_SB(1, 1), cB + hstep + kstep, voffB);
        PG8_WAIT_V(6); PG8_BAR;
    }
    for (;;) {
        const bool has_next = S.next(ui + 1, nxt);
        const char* nA = has_next ? (const char*)g.A + (size_t)nxt.pm * tstep + (size_t)nxt.ks * K * 2 : cA; const char* nB = has_next ? (const char*)g.Bt + (size_t)nxt.pn * tstep + (size_t)nxt.ks * K * 2 : cB;
        for (int t = 0; t < nt; t += 2) {
            const bool last = (t == nt - 2);
            const char* a1 = cA + (size_t)(t + 1) * kstep;
            const char* a2 = last ? nA : cA + (size_t)(t + 2) * kstep; const char* b2 = last ? nB : cB + (size_t)(t + 2) * kstep;
            const char* a3 = a2 + kstep; const char* b3 = b2 + kstep;
            if (last && has_next) S.a_ready(nxt);
            if constexpr (SP2) {
            PG8_LDB(B0, 0, 0); PG8_LDB(B1, 0, 1); PG8_SCHED; PG8_LDA(At, 0, 0); PG8_STAGE(PG8_SA(1, 1), a1 + hstep, voffA);
            PG8_WAIT_V(8); PG8_WAIT_L(0); PG8_BAR; PG8_MMA(0, 0, At, B0); PG8_MMA(0, 1, At, B1); PG8_BAR; PG8_SCHED;
            PG8_LDA(At, 0, 1); PG8_STAGE(PG8_SB(0, 0), b2, voffB); PG8_STAGE(PG8_SB(0, 1), b2 + hstep, voffB); PG8_STAGE(PG8_SA(0, 0), a2, voffA);
            PG8_WAIT_V(8); PG8_WAIT_L(0); PG8_BAR; PG8_MMA(1, 0, At, B0); PG8_MMA(1, 1, At, B1); PG8_BAR; PG8_SCHED;
            PG8_LDB(B0, 1, 0); PG8_LDB(B1, 1, 1); PG8_SCHED; PG8_LDA(At, 1, 0); PG8_STAGE(PG8_SA(0, 1), a2 + hstep, voffA);
            PG8_WAIT_V(8); PG8_WAIT_L(0); PG8_BAR; PG8_MMA(0, 0, At, B0); PG8_MMA(0, 1, At, B1); PG8_BAR; PG8_SCHED;
            PG8_LDA(At, 1, 1); PG8_STAGE(PG8_SB(1, 0), b3, voffB); PG8_STAGE(PG8_SB(1, 1), b3 + hstep, voffB); PG8_STAGE(PG8_SA(1, 0), a3, voffA);
            PG8_WAIT_V(8); PG8_WAIT_L(0); PG8_BAR; PG8_MMA(1, 0, At, B0); PG8_MMA(1, 1, At, B1); PG8_BAR; PG8_SCHED;
            } else {
            PG8_LDB(B0, 0, 0); PG8_SCHED; PG8_LDA(At, 0, 0); PG8_STAGE(PG8_SA(1, 1), a1 + hstep, voffA);
            PG8_WAIT_L(8); PG8_BAR; PG8_WAIT_L(0); PG8_MMA(0, 0, At, B0); PG8_BAR; PG8_SCHED;
            PG8_LDB(B1, 0, 1); PG8_STAGE(PG8_SB(0, 0), b2, voffB);
            PG8_BAR; PG8_WAIT_L(0); PG8_MMA(0, 1, At, B1); PG8_BAR;
            PG8_LDA(At, 0, 1); PG8_STAGE(PG8_SA(0, 0), a2, voffA);
            PG8_BAR; PG8_WAIT_L(0); PG8_MMA(1, 0, At, B0); PG8_BAR; PG8_SCHED;
            PG8_STAGE(PG8_SB(0, 1), b2 + hstep, voffB);
            PG8_WAIT_V(6); PG8_BAR; PG8_MMA(1, 1, At, B1); PG8_BAR;
            PG8_LDB(B0, 1, 0); PG8_SCHED; PG8_LDA(At, 1, 0); PG8_STAGE(PG8_SA(0, 1), a2 + hstep, voffA);
            PG8_WAIT_L(8); PG8_BAR; PG8_WAIT_L(0); PG8_MMA(0, 0, At, B0); PG8_BAR; PG8_SCHED;
            PG8_LDB(B1, 1, 1); PG8_STAGE(PG8_SB(1, 0), b3, voffB);
            PG8_BAR; PG8_WAIT_L(0); PG8_MMA(0, 1, At, B1); PG8_BAR;
            PG8_LDA(At, 1, 1); PG8_STAGE(PG8_SA(1, 0), a3, voffA);
            PG8_BAR; PG8_WAIT_L(0); PG8_MMA(1, 0, At, B0); PG8_BAR; PG8_SCHED;
            PG8_STAGE(PG8_SB(1, 1), b3 + hstep, voffB);
            PG8_WAIT_V(6); PG8_BAR; PG8_MMA(1, 1, At, B1); PG8_BAR;
            }
        }
        if constexpr (ALIGN_EPI) { if (wr == 0) PG8_BAR; }
        if constexpr (!Epi::AFTER_DRAIN) { E(acc, cur, wr, wc, fr, fq); S.done(cur); }
        if (!has_next) break;
#pragma unroll
        for (int a = 0; a < 2; ++a)
#pragma unroll
            for (int b = 0; b < 2; ++b)
#pragma unroll
                for (int m = 0; m < 4; ++m)
#pragma unroll
                    for (int n = 0; n < 2; ++n) acc[a][b][m][n] = (f32x4){0.f, 0.f, 0.f, 0.f};
        cur = nxt; cA = nA; cB = nB; ++ui;
        if constexpr (ALIGN_EPI) { if (wr == 1) PG8_BAR; }
    }
    PG8_WAIT_V(0);
    if constexpr (!ALIGN_EPI) { if (wr == 0) PG8_BAR; }
    PG8_BAR;
    if constexpr (Epi::AFTER_DRAIN) { E.fused(acc, cur, wr, wc, fr, fq, lds, wid, lane); S.done(cur); }
#undef PG8_SA
#undef PG8_SB
#undef PG8_STAGE
#undef PG8_LDA
#undef PG8_LDB
#undef PG8_MMA
#undef PG8_WAIT_V
#undef PG8_WAIT_L
#undef PG8_BAR
#undef PG8_SCHED
}
}

constexpr int DM = 2048, NB = 4, SEQ = 2048, TP = 2064, NS = 128, TS = 4;
constexpr int MP = NB * TP;
constexpr int MR = MP + NS * TS;
constexpr int MPAD = 8960;
constexpr int RC = 3360;
constexpr int NIN = 7680;
constexpr int DFF = 5632;
constexpr int NTP = 2068;

constexpr size_t MiB = 1u << 20;
constexpr size_t ARR = (size_t)MR * 1024 * 4;
constexpr size_t WS_LT = 128 * 1024;
constexpr size_t WS_CS = 1 * MiB, WS_BON = 3 * MiB + 256 * 1024, WS_WOUT = 4 * MiB, WS_XN = 12 * MiB, WS_ZA = 47 * MiB, WS_ZB = 162 * MiB;
constexpr size_t WS_W = 232 * MiB, WS_RKAB = WS_W + ARR, WS_G = WS_RKAB + 2 * ARR, WS_O = WS_G + ARR, WS_ORET = WS_O + ARR;
constexpr size_t WS_R = WS_W;
constexpr size_t WS_WIN = 232 * MiB;
constexpr size_t WS_H = 47 * MiB, WS_WGU = WS_ORET + (size_t)MP * 1024 * 4, WS_WDN = WS_WGU + 44 * MiB, WS_ACT = 232 * MiB;
constexpr size_t WS_PART = WS_G;
constexpr size_t WS_END = WS_WDN + 22 * MiB;
static_assert(WS_END <= 512 * MiB, "ws map");
static_assert(WS_ZA + (size_t)MPAD * RC * 4 <= WS_ZB && WS_ZB + (size_t)MPAD * 4096 * 2 <= WS_R && WS_ACT + (size_t)MPAD * 5632 * 2 <= WS_G && WS_PART + 52 * MiB <= WS_WGU, "ws map 2");
static_assert(WS_CS + (size_t)NTP * 128 * 8 <= WS_BON && WS_BON + (size_t)MR * 16 * 4 <= WS_WOUT, "ws map 3");

constexpr size_t OUT_YP = 0, OUT_YS = 16777216, OUT_SHP = 17825792, OUT_RWP = 17839232, OUT_RTP = 18101376, OUT_SHS = 19149952, OUT_RWS = 19580032, OUT_RTS = 27968640;

constexpr int LDS_BYTES = 147456;
constexpr int NPH = 10;

#define LAS __attribute__((address_space(3)))
typedef unsigned short bf16;
typedef unsigned v4u __attribute__((ext_vector_type(4)));
typedef unsigned v2u __attribute__((ext_vector_type(2)));
typedef float f32x4 __attribute__((ext_vector_type(4)));
typedef float f32x2 __attribute__((ext_vector_type(2)));
typedef short bf16x8 __attribute__((ext_vector_type(8)));

__device__ __forceinline__ unsigned f2bf(float f) { unsigned u = __builtin_bit_cast(unsigned, f); return (u + 0x7fffu + ((u >> 16) & 1u)) >> 16; }
__device__ __forceinline__ unsigned pk2(float lo, float hi) { return f2bf(lo) | (f2bf(hi) << 16); }
__device__ __forceinline__ float bf2f(unsigned b) { return __builtin_bit_cast(float, b << 16); }
__device__ __forceinline__ float wave_sum(float v) {
#pragma unroll
    for (int o = 1; o < 64; o <<= 1) v += __shfl_xor(v, o);
    return v;
}
__device__ __forceinline__ float half_sum(float v) {
#pragma unroll
    for (int o = 1; o < 32; o <<= 1) v += __shfl_xor(v, o);
    return v;
}
#define DPP_ROR(x, n) __builtin_bit_cast(float, __builtin_amdgcn_update_dpp(0, __builtin_bit_cast(int, (x)), 0x120 + (n), 0xf, 0xf, false))
__device__ __forceinline__ float rowsum16(float x) {
    x += DPP_ROR(x, 8); x += DPP_ROR(x, 4); x += DPP_ROR(x, 2); x += DPP_ROR(x, 1);
    return x;
}

__device__ __forceinline__ float fma_s(float a, float b, float c) { float d; asm("v_fma_f32 %0, %1, %2, %3" : "=v"(d) : "v"(a), "v"(b), "v"(c)); return d; }
__device__ __forceinline__ float mul_s(float a, float b) { float d; asm("v_mul_f32 %0, %1, %2" : "=v"(d) : "v"(a), "v"(b)); return d; }
__device__ __forceinline__ float add_s(float a, float b) { float d; asm("v_add_f32 %0, %1, %2" : "=v"(d) : "v"(a), "v"(b)); return d; }
#define SCAN_STEP(S, r4, w4, k4, a4, b4, vi, ov) do { \
    const float sa_ = rowsum16(add_s(fma_s(S.y, a4.y, mul_s(S.x, a4.x)), fma_s(S.w, a4.w, mul_s(S.z, a4.z)))); \
    S.x = fma_s(S.x, w4.x, fma_s(sa_, b4.x, mul_s(vi, k4.x))); S.y = fma_s(S.y, w4.y, fma_s(sa_, b4.y, mul_s(vi, k4.y))); \
    S.z = fma_s(S.z, w4.z, fma_s(sa_, b4.z, mul_s(vi, k4.z))); S.w = fma_s(S.w, w4.w, fma_s(sa_, b4.w, mul_s(vi, k4.w))); \
    ov = rowsum16(add_s(fma_s(S.y, r4.y, mul_s(S.x, r4.x)), fma_s(S.w, r4.w, mul_s(S.z, r4.z)))); } while (0)

__device__ __forceinline__ float fexp(float x) { return __expf(x); }
__device__ __forceinline__ float frcp(float x) { return __builtin_amdgcn_rcpf(x); }
__device__ __forceinline__ float fsig(float x) { return frcp(1.0f + __expf(-x)); }
__device__ __forceinline__ float ftanh(float x) { return 1.0f - 2.0f * frcp(1.0f + __expf(2.0f * x)); }
__device__ __forceinline__ float sigmoid_f(float x) { return 1.0f / (1.0f + expf(-x)); }

struct Args { const float* in[25]; float* out; unsigned char* ws; int ph_lo, ph_hi, sub, pad; };

__device__ __forceinline__ void transpose_item(const float* W, int K, int N, bf16* WT, int mode, LAS float* scr, int item, int lane) {
    const int nblk = N / 32, kb = item / nblk, nb = item % nblk, k0 = 64 * kb, n0 = 32 * nb;
#pragma unroll
    for (int i = 0; i < 32; ++i) { const int kk = 2 * i + (lane >> 5); scr[kk * 33 + (lane & 31)] = __builtin_nontemporal_load(W + (size_t)(k0 + kk) * N + n0 + (lane & 31)); }
    asm volatile("s_waitcnt lgkmcnt(0)" ::: "memory");
    int r0 = n0;
    if (mode == 1) r0 = n0 < RC ? n0 : n0 + 224;
    else if (mode == 2) r0 = 256 * (n0 >> 7) + (n0 & 127);
    else if (mode == 3) r0 = 256 * (n0 >> 7) + (n0 & 127) + 128;
    const int c = lane & 7;
#pragma unroll
    for (int j = 0; j < 4; ++j) { const int n = (lane >> 3) + 8 * j; const LAS float* s = scr + (8 * c) * 33 + n;
        v4u o; o.x = pk2(s[0 * 33], s[1 * 33]); o.y = pk2(s[2 * 33], s[3 * 33]); o.z = pk2(s[4 * 33], s[5 * 33]); o.w = pk2(s[6 * 33], s[7 * 33]);
        *(v4u*)(WT + (size_t)(r0 + n) * K + k0 + 8 * c) = o; }
    asm volatile("s_waitcnt lgkmcnt(0)" ::: "memory");
}
__device__ __forceinline__ void rms_row_bf16(const float* xrow, const float* gain, bf16* orow, int lane) {
    f32x4 v[8]; float s = 0.f;
#pragma unroll
    for (int j = 0; j < 8; ++j) { v[j] = *(const f32x4*)(xrow + 4 * lane + 256 * j); s += (v[j].x * v[j].x + v[j].y * v[j].y) + (v[j].z * v[j].z + v[j].w * v[j].w); }
    const float rs = 1.0f / sqrtf(wave_sum(s) * (1.0f / 2048.0f) + 1e-6f);
#pragma unroll
    for (int j = 0; j < 8; ++j) { const f32x4 g = *(const f32x4*)(gain + 4 * lane + 256 * j);
        v2u o; o.x = pk2(v[j].x * rs * g.x, v[j].y * rs * g.y); o.y = pk2(v[j].z * rs * g.z, v[j].w * rs * g.w);
        *(v2u*)(orow + 4 * lane + 256 * j) = o; }
}
__device__ __forceinline__ void rms_rows2_bf16(const float* x0, const float* x1, const float* gain, bf16* o0, bf16* o1, int lane) {
    f32x4 v[8], u[8]; float s = 0.f, t = 0.f;
#pragma unroll
    for (int j = 0; j < 8; ++j) { v[j] = *(const f32x4*)(x0 + 4 * lane + 256 * j); u[j] = *(const f32x4*)(x1 + 4 * lane + 256 * j); }
#pragma unroll
    for (int j = 0; j < 8; ++j) { s += (v[j].x * v[j].x + v[j].y * v[j].y) + (v[j].z * v[j].z + v[j].w * v[j].w); t += (u[j].x * u[j].x + u[j].y * u[j].y) + (u[j].z * u[j].z + u[j].w * u[j].w); }
    const float rs = 1.0f / sqrtf(wave_sum(s) * (1.0f / 2048.0f) + 1e-6f), rt = 1.0f / sqrtf(wave_sum(t) * (1.0f / 2048.0f) + 1e-6f);
#pragma unroll
    for (int j = 0; j < 8; ++j) { const f32x4 g = *(const f32x4*)(gain + 4 * lane + 256 * j);
        v2u a; a.x = pk2(v[j].x * rs * g.x, v[j].y * rs * g.y); a.y = pk2(v[j].z * rs * g.z, v[j].w * rs * g.w); *(v2u*)(o0 + 4 * lane + 256 * j) = a;
        v2u b; b.x = pk2(u[j].x * rt * g.x, u[j].y * rt * g.y); b.y = pk2(u[j].z * rt * g.z, u[j].w * rt * g.w); *(v2u*)(o1 + 4 * lane + 256 * j) = b; }
}
__device__ __forceinline__ void zero_row_bf16(bf16* orow, int lane) {
#pragma unroll
    for (int j = 0; j < 8; ++j) *(v2u*)(orow + 4 * lane + 256 * j) = (v2u){0u, 0u};
}
__device__ __forceinline__ float zprev_val(const float* ZA, const float* sshift, int row, int col) {
    if (row < MP) { const int p = row % TP; return p == 0 ? 0.f : ZA[(size_t)(row - 1) * RC + col]; }
    const int r = row - MP; return (r & 3) == 0 ? sshift[(size_t)(r >> 2) * RC + col] : ZA[(size_t)(row - 1) * RC + col];
}

template <int MT, int NT, int KS>
__device__ __forceinline__ void wave_mma(f32x4 (&acc)[MT][NT], const LAS unsigned char* A, int lda, const LAS unsigned char* B, int ldb, int fr, int fq) {
#pragma unroll 2
    for (int ks = 0; ks < KS; ++ks) {
        bf16x8 a[MT], b[NT];
#pragma unroll
        for (int mi = 0; mi < MT; ++mi) a[mi] = *(const LAS bf16x8*)(A + (mi * 16 + fr) * lda + (ks * 32 + fq * 8) * 2);
#pragma unroll
        for (int ni = 0; ni < NT; ++ni) b[ni] = *(const LAS bf16x8*)(B + (ni * 16 + fr) * ldb + (ks * 32 + fq * 8) * 2);
#pragma unroll
        for (int mi = 0; mi < MT; ++mi)
#pragma unroll
            for (int ni = 0; ni < NT; ++ni) acc[mi][ni] = __builtin_amdgcn_mfma_f32_16x16x32_bf16(a[mi], b[ni], acc[mi][ni], 0, 0, 0);
    }
}

__device__ __forceinline__ float ret_lg2(int h) { return h == 0 ? -0.04580368961312479f : (h == 1 ? -0.02272007650008353f : (h == 2 ? -0.011315313227834146f : -0.005646563141142063f)); }

__device__ __forceinline__ void ret_prompt_unit(LAS unsigned char* L, const bf16* ZB, float* ORET, float* retp, int unit, int tid) {
    const int lane = tid & 63, wave = tid >> 6, fr = lane & 15, fq = lane >> 4;
    const int b = unit >> 5, h = (unit >> 3) & 3, es = unit & 7;
    const float lg2 = ret_lg2(h);
    LAS unsigned char* Q = L; LAS unsigned char* R2 = L + 67584; LAS unsigned char* VT = L + 137216;
    LAS unsigned char* P = R2; LAS unsigned char* ST = R2 + 34816; LAS unsigned char* KT = R2;
    f32x4 S[2][2];
#pragma unroll
    for (int a = 0; a < 2; ++a)
#pragma unroll
        for (int c = 0; c < 2; ++c) S[a][c] = (f32x4){0.f, 0.f, 0.f, 0.f};
    v4u qn[8], kn[8], vn;
    const int vj = tid & 127, veg = tid >> 7;
#define RET_LOAD(ch_) do { const int C_ = (ch_) == 0 ? 16 : 128, rb_ = b * TP + ((ch_) == 0 ? 0 : 16 + ((ch_) - 1) * 128); \
        const bf16* src_ = ZB + (size_t)(rb_ + vj) * 4096 + h * 256 + veg * 8; \
        _Pragma("unroll") for (int it = 0; it < 8; ++it) { qn[it] = (v4u){0u, 0u, 0u, 0u}; kn[it] = qn[it]; \
            if (vj < C_) { qn[it] = *(const v4u*)(src_ + it * 32); kn[it] = *(const v4u*)(src_ + 1024 + it * 32); } } \
        vn = (v4u){0u, 0u, 0u, 0u}; if (vj < C_) vn = *(const v4u*)(src_ + 2048 + es * 32); } while (0)
    RET_LOAD(0);
    for (int ch = 0; ch < 17; ++ch) {
        const int C = ch == 0 ? 16 : 128, tok0 = ch == 0 ? 0 : 16 + (ch - 1) * 128, rowbase = b * TP + tok0;
#pragma unroll
        for (int it = 0; it < 8; ++it) {
            *(LAS v4u*)(Q + vj * 528 + veg * 16 + it * 64) = qn[it];
            *(LAS v4u*)(R2 + vj * 528 + veg * 16 + it * 64) = kn[it]; }
#pragma unroll
        for (int x = 0; x < 4; ++x) { const unsigned w = vn[x];
            *(LAS unsigned short*)(VT + (veg * 8 + 2 * x) * 272 + vj * 2) = (unsigned short)(w & 0xffffu);
            *(LAS unsigned short*)(VT + (veg * 8 + 2 * x + 1) * 272 + vj * 2) = (unsigned short)(w >> 16); }
        __syncthreads();
        f32x4 sc[4][2];
#pragma unroll
        for (int a = 0; a < 4; ++a)
#pragma unroll
            for (int c = 0; c < 2; ++c) sc[a][c] = (f32x4){0.f, 0.f, 0.f, 0.f};
        const int mt0 = (wave >> 1) * 2, nt0 = (wave & 1) * 4;
        wave_mma<4, 2, 8>(sc, R2 + nt0 * 16 * 528, 528, Q + mt0 * 16 * 528, 528, fr, fq);
        __syncthreads();
        float lg2v = lg2; asm volatile("" : "+v"(lg2v));
        const float gi1 = exp2f(-lg2v), gi2 = gi1 * gi1, gi3 = gi2 * gi1;
#pragma unroll
        for (int mi = 0; mi < 4; ++mi)
#pragma unroll
            for (int ni = 0; ni < 2; ++ni) { const int j0 = (nt0 + mi) * 16 + 4 * fq, i = (mt0 + ni) * 16 + fr;
                const float e0 = exp2f(lg2v * (float)(i - j0));
                float pv[4];
                pv[0] = i >= j0 ? sc[mi][ni][0] * e0 : 0.f; pv[1] = i >= j0 + 1 ? sc[mi][ni][1] * (e0 * gi1) : 0.f;
                pv[2] = i >= j0 + 2 ? sc[mi][ni][2] * (e0 * gi2) : 0.f; pv[3] = i >= j0 + 3 ? sc[mi][ni][3] * (e0 * gi3) : 0.f;
                v2u w; w.x = pk2(pv[0], pv[1]); w.y = pk2(pv[2], pv[3]);
                *(LAS v2u*)(P + i * 272 + j0 * 2) = w; }
#pragma unroll
        for (int dt = 0; dt < 2; ++dt)
#pragma unroll
            for (int et = 0; et < 2; ++et) { const int d = (2 * wave + dt) * 16 + 4 * fq, e = et * 16 + fr;
                v2u w; w.x = pk2(S[dt][et][0], S[dt][et][1]); w.y = pk2(S[dt][et][2], S[dt][et][3]);
                *(LAS v2u*)(ST + e * 528 + d * 2) = w; }
        __syncthreads();
        f32x4 o1[1][2], o2[1][2];
        o1[0][0] = o1[0][1] = o2[0][0] = o2[0][1] = (f32x4){0.f, 0.f, 0.f, 0.f};
        wave_mma<1, 2, 4>(o1, P + wave * 16 * 272, 272, VT, 272, fr, fq);
        wave_mma<1, 2, 8>(o2, Q + wave * 16 * 528, 528, ST, 528, fr, fq);
#pragma unroll
        for (int ni = 0; ni < 2; ++ni)
#pragma unroll
            for (int r = 0; r < 4; ++r) { const int i = wave * 16 + 4 * fq + r, e = ni * 16 + fr;
                if (i < C) ORET[(size_t)(rowbase + i) * 1024 + h * 256 + es * 32 + e] = o1[0][ni][r] + exp2f(lg2v * (float)(i + 1)) * o2[0][ni][r]; }
        __syncthreads();
        const float sdec = vj < C ? exp2f(lg2v * (float)(C - 1 - vj)) : 0.f;
#pragma unroll
        for (int it = 0; it < 8; ++it) { const int j = vj, db = veg + 4 * it;
#pragma unroll
            for (int x = 0; x < 4; ++x) { const unsigned w = kn[it][x];
                *(LAS unsigned short*)(KT + (db * 8 + 2 * x) * 272 + j * 2) = (unsigned short)f2bf(bf2f(w & 0xffffu) * sdec);
                *(LAS unsigned short*)(KT + (db * 8 + 2 * x + 1) * 272 + j * 2) = (unsigned short)f2bf(bf2f(w >> 16) * sdec); } }
        if (ch + 1 < 17) RET_LOAD(ch + 1);
        __syncthreads();
        const float gC = exp2f(lg2 * (float)C);
#pragma unroll
        for (int a = 0; a < 2; ++a)
#pragma unroll
            for (int c = 0; c < 2; ++c) S[a][c] *= gC;
        wave_mma<2, 2, 4>(S, KT + (2 * wave) * 16 * 272, 272, VT, 272, fr, fq);
        __syncthreads();
    }
#undef RET_LOAD
#pragma unroll
    for (int dt = 0; dt < 2; ++dt)
#pragma unroll
        for (int et = 0; et < 2; ++et)
#pragma unroll
            for (int r = 0; r < 4; ++r) { const int d = (2 * wave + dt) * 16 + 4 * fq + r, e = es * 32 + et * 16 + fr;
                retp[((size_t)(b * 4 + h) * 256 + d) * 256 + e] = S[dt][et][r]; }
}

__device__ __forceinline__ void ret_sample_unit(LAS unsigned char* L, const bf16* ZB, const float* sret, float* rets, bf16* OAB, int unit, int tid) {
    const int lane = tid & 63, wave = tid >> 6;
    const int s = unit >> 2, h = unit & 3;
    const float lg2 = ret_lg2(h);
    LAS float* qs = (LAS float*)L;
    LAS float* ks = qs + 1024;
    LAS float* qr = ks + 1024;
    LAS float* kr = qr + 1024;
    LAS float* scs = kr + 1024;
    LAS float* part = scs + 16;
    LAS float* red = part + 2048;
    const int rowb = MP + 4 * s;
    for (int idx = tid; idx < 1024; idx += 512) { const int i = idx >> 8, d = idx & 255;
        const bf16* src = ZB + (size_t)(rowb + i) * 4096 + h * 256 + d;
        const float q = bf2f(src[0]), k = bf2f(src[1024]);
        qr[idx] = q; kr[idx] = k; qs[d * 4 + i] = q * exp2f(lg2 * (float)(i + 1)); ks[d * 4 + i] = k * exp2f(lg2 * (float)(3 - i)); }
    __syncthreads();
#pragma unroll
    for (int pp = 0; pp < 2; ++pp) { const int pr = 2 * wave + pp, i = pr >> 2, j = pr & 3;
        const f32x4 a = *(const LAS f32x4*)(qr + i * 256 + 4 * lane), c = *(const LAS f32x4*)(kr + j * 256 + 4 * lane);
        float d = (a.x * c.x + a.y * c.y) + (a.z * c.z + a.w * c.w); d = wave_sum(d);
        if (lane == 0) scs[pr] = i >= j ? d * exp2f(lg2 * (float)(i - j)) : 0.f; }
    const int e = tid & 255, hf = tid >> 8;
    float v[4];
#pragma unroll
    for (int j = 0; j < 4; ++j) v[j] = bf2f(ZB[(size_t)(rowb + j) * 4096 + 2048 + h * 256 + e]);
    const float g4 = exp2f(lg2 * 4.0f);
    const float* S0 = sret + ((size_t)(s * 4 + h) * 256 + hf * 128) * 256 + e;
    float* S1 = rets + ((size_t)(s * 4 + h) * 256 + hf * 128) * 256 + e;
    float o[4] = {0.f, 0.f, 0.f, 0.f};
    for (int dd = 0; dd < 128; dd += 8) {
        float sv[8];
#pragma unroll
        for (int u = 0; u < 8; ++u) sv[u] = S0[(size_t)(dd + u) * 256];
#pragma unroll
        for (int u = 0; u < 8; ++u) { const int d = hf * 128 + dd + u;
            const f32x4 q4 = *(const LAS f32x4*)(qs + d * 4), k4 = *(const LAS f32x4*)(ks + d * 4);
            o[0] += q4.x * sv[u]; o[1] += q4.y * sv[u]; o[2] += q4.z * sv[u]; o[3] += q4.w * sv[u];
            S1[(size_t)(dd + u) * 256] = g4 * sv[u] + ((k4.x * v[0] + k4.y * v[1]) + (k4.z * v[2] + k4.w * v[3])); }
    }
#pragma unroll
    for (int i = 0; i < 4; ++i) part[(hf * 4 + i) * 256 + e] = o[i];
    __syncthreads();
    float oo[2], ss[2];
#pragma unroll
    for (int ii = 0; ii < 2; ++ii) { const int i = hf * 2 + ii;
        float x = part[i * 256 + e] + part[(4 + i) * 256 + e];
#pragma unroll
        for (int j = 0; j < 4; ++j) x += scs[i * 4 + j] * v[j];
        oo[ii] = x; ss[ii] = wave_sum(x * x); }
    if (lane == 0) { red[wave * 2] = ss[0]; red[wave * 2 + 1] = ss[1]; }
    __syncthreads();
#pragma unroll
    for (int ii = 0; ii < 2; ++ii) { const int i = hf * 2 + ii; const int w0 = hf * 4;
        const float tot = (red[w0 * 2 + ii] + red[(w0 + 1) * 2 + ii]) + (red[(w0 + 2) * 2 + ii] + red[(w0 + 3) * 2 + ii]);
        const float rs = 1.0f / sqrtf(tot * (1.0f / 256.0f) + 1e-6f);
        const float g = bf2f(ZB[(size_t)(rowb + i) * 4096 + 3072 + h * 256 + e]);
        OAB[(size_t)(rowb + i) * 2048 + 1024 + h * 256 + e] = (bf16)f2bf(oo[ii] * rs * (g / (1.0f + expf(-g)))); }
    __syncthreads();
}


#define IN_(k) (args.in[k])
#define x_prompt IN_(0)
#define x_sample IN_(1)
#define state_shift IN_(2)
#define state_rwkv IN_(3)
#define state_ret IN_(4)
#define meta IN_(5)
#define norm_mix IN_(6)
#define w_in IN_(7)
#define mu IN_(8)
#define w0 IN_(9)
#define w2 IN_(10)
#define a0 IN_(11)
#define a2 IN_(12)
#define g2 IN_(13)
#define k_k IN_(14)
#define k_a IN_(15)
#define r_k IN_(16)
#define ln_w IN_(17)
#define ln_b IN_(18)
#define w_out IN_(19)
#define norm_ffn IN_(20)
#define w_gate IN_(21)
#define w_up IN_(22)
#define w_down IN_(23)
#define norm_final IN_(24)
#define out (args.out)
#define CS ((float*)(ws + WS_CS))
#define BON ((float*)(ws + WS_BON))
#define WT_IN ((bf16*)(ws + WS_WIN))
#define WT_OUT ((bf16*)(ws + WS_WOUT))
#define WT_GU ((bf16*)(ws + WS_WGU))
#define WT_DN ((bf16*)(ws + WS_WDN))
#define XN ((bf16*)(ws + WS_XN))
#define OAB ((bf16*)(ws + WS_XN))
#define ZA ((float*)(ws + WS_ZA))
#define ZB ((bf16*)(ws + WS_ZB))
#define RKAB ((bf16*)(ws + WS_RKAB))
#define aW ((float*)(ws + WS_W))
#define aG ((float*)(ws + WS_G))
#define aO ((float*)(ws + WS_O))
#define ORET ((float*)(ws + WS_ORET))
#define H ((float*)(ws + WS_H))
#define ACT ((bf16*)(ws + WS_ACT))

typedef __attribute__((address_space(1))) unsigned gu32;
#define RLX_AGENT __ATOMIC_RELAXED, __HIP_MEMORY_SCOPE_AGENT
#define XB_TMO      128
#define XB_XCNT(j)  (256  + 64 * (j))
#define XB_XSUB(j)  (1280 + 64 * (j))
#define XB_XGEN(j)  (2304 + 64 * (j))
#define XB_TOP      3328
#define XB_TOPGEN   3392
#define XCD_BAR_WORDS 3456
#define XB_SPIN_CAP (1u << 18)

__device__ __forceinline__ unsigned xb_ld(unsigned* p)              { return __hip_atomic_load(p, __ATOMIC_RELAXED, __HIP_MEMORY_SCOPE_AGENT); }
__device__ __forceinline__ unsigned xb_add(unsigned* p, unsigned v) { return __hip_atomic_fetch_add(p, v, __ATOMIC_RELAXED, __HIP_MEMORY_SCOPE_AGENT); }
__device__ __forceinline__ unsigned xb_xcc_id() { return (unsigned)__builtin_amdgcn_s_getreg((3 << 11) | 20) & 0xFu; }
#define XB_SPIN(cond, bar) do { unsigned _sp = 0; while (cond) { __builtin_amdgcn_s_sleep(1); \
    if ((++_sp & 255u) == 0u) { if (xb_ld(&(bar)[XB_TMO])) break; if (_sp > XB_SPIN_CAP) { atomicAdd(&(bar)[XB_TMO], 1u); break; } } } } while (0)

struct XcdBarrier {
    unsigned* bar; unsigned x;
    volatile LAS unsigned* st;
};

__device__ __forceinline__ XcdBarrier xcd_barrier_post(unsigned* bar, volatile LAS unsigned* st) {
    XcdBarrier b; b.bar = bar; b.x = xb_xcc_id(); b.st = st;
    if (threadIdx.x == 0) (void)xb_add(&bar[XB_XCNT(b.x)], 1u);
    return b;
}
__device__ __forceinline__ void xcd_barrier_complete(unsigned* bar, unsigned x, unsigned& nloc, unsigned& nx) {
    const unsigned G = gridDim.x * gridDim.y * gridDim.z;
    unsigned sum, cnt, mine, sp = 0u;
    for (;;) {
        sum = 0u; cnt = 0u; mine = 0u;
#pragma unroll
        for (unsigned j = 0; j < 16; ++j) { const unsigned c = xb_ld(&bar[XB_XCNT(j)]); sum += c; cnt += (c > 0u) ? 1u : 0u; mine = (j == x) ? c : mine; }
        if (sum == G) break;
        __builtin_amdgcn_s_sleep(1);
        if ((++sp & 255u) == 0u) { if (xb_ld(&bar[XB_TMO])) break; if (sp > XB_SPIN_CAP) { atomicAdd(&bar[XB_TMO], 1u); break; } }
    }
    nloc = mine > 0u ? mine : 1u; nx = cnt > 0u ? cnt : 1u;
}

__device__ __forceinline__ void xcd_barrier(const XcdBarrier& b) {
    asm volatile("s_waitcnt vmcnt(0)" ::: "memory");
    __syncthreads();
    if (threadIdx.x == 0) {
        unsigned* bar = b.bar;
        __builtin_amdgcn_s_waitcnt(0);
        unsigned nloc = b.st[0], nx = b.st[1];
        if (nloc == 0u) { xcd_barrier_complete(bar, b.x, nloc, nx); b.st[0] = nloc; b.st[1] = nx; }
        const unsigned old = xb_add(&bar[XB_XSUB(b.x)], 1u);
        const unsigned gen = old / nloc;
        if (old + 1u == (gen + 1u) * nloc) {
            __builtin_amdgcn_fence(__ATOMIC_RELEASE, "agent");
            asm volatile("s_waitcnt vmcnt(0)" ::: "memory");
            const unsigned og = xb_add(&bar[XB_TOP], 1u);
            const unsigned tg = og / nx;
            if (og + 1u == (tg + 1u) * nx) xb_add(&bar[XB_TOPGEN], 1u);
            else XB_SPIN(xb_ld(&bar[XB_TOPGEN]) == tg, bar);
            __builtin_amdgcn_fence(__ATOMIC_ACQUIRE, "agent");
            xb_add(&bar[XB_XGEN(b.x)], 1u);
            asm volatile("s_waitcnt vmcnt(0)" ::: "memory");
        } else {
            XB_SPIN(xb_ld(&bar[XB_XGEN(b.x)]) == gen, bar);
            __builtin_amdgcn_fence(__ATOMIC_ACQUIRE, "agent");
            asm volatile("s_waitcnt vmcnt(0)" ::: "memory");
        }
    }
    __syncthreads();
}

constexpr int MISC_OFF = 147328;


__device__ __forceinline__ void rkab_unpack(const v4u& X, const v4u& Y, f32x4& r4, f32x4& k4, f32x4& a4, f32x4& b4) {
    r4 = (f32x4){bf2f(X.x & 0xffffu), bf2f(X.z & 0xffffu), bf2f(Y.x & 0xffffu), bf2f(Y.z & 0xffffu)};
    k4 = (f32x4){bf2f(X.x >> 16), bf2f(X.z >> 16), bf2f(Y.x >> 16), bf2f(Y.z >> 16)};
    a4 = (f32x4){bf2f(X.y & 0xffffu), bf2f(X.w & 0xffffu), bf2f(Y.y & 0xffffu), bf2f(Y.w & 0xffffu)};
    b4 = (f32x4){bf2f(X.y >> 16), bf2f(X.w >> 16), bf2f(Y.y >> 16), bf2f(Y.w >> 16)};
}
__device__ __forceinline__ void sample_scan_units(const unsigned char* ws, const float* p_rwkv, const float* p_shift, const float* p_mu, float* outp, int wu0, int wu1, int stride, int lane) {
    const int ri = lane >> 4, cq = lane & 15;
    for (int wub = wu0; wub < wu1; wub += 2 * stride) {
        f32x4 S[2]; float vmu[2], zprev[2]; int vcol[2], hh[2], ss[2], irow[2]; bool ok[2];
#pragma unroll
        for (int q = 0; q < 2; ++q) { const int wu = wub + q * stride; ok[q] = wu < wu1; const int wuc = ok[q] ? wu : wub;
            ss[q] = wuc >> 8; hh[q] = (wuc >> 4) & 15; irow[q] = (wuc & 15) * 4 + ri;
            S[q] = *(const f32x4*)(p_rwkv + ((size_t)((ss[q] * 16 + hh[q]) * 64 + irow[q])) * 64 + cq * 4);
            vcol[q] = 2048 + hh[q] * 64 + irow[q]; vmu[q] = p_mu[vcol[q]]; zprev[q] = p_shift[(size_t)ss[q] * RC + vcol[q]]; }
#pragma unroll
        for (int t = 0; t < 4; ++t) {
            f32x4 r4[2], w4[2], k4[2], a4[2], b4[2]; float z[2];
#pragma unroll
            for (int q = 0; q < 2; ++q) { const int row = MP + 4 * ss[q] + t; const size_t o = (size_t)row * 1024 + hh[q] * 64 + cq * 4;
                w4[q] = *(const f32x4*)(aW + o); { const v4u X_ = *(const v4u*)(RKAB + o * 4), Y_ = *(const v4u*)(RKAB + o * 4 + 8); rkab_unpack(X_, Y_, r4[q], k4[q], a4[q], b4[q]); }
                z[q] = ZA[(size_t)row * RC + vcol[q]]; }
#pragma unroll
            for (int q = 0; q < 2; ++q) { const int row = MP + 4 * ss[q] + t; const float vi = z[q] + vmu[q] * (zprev[q] - z[q]); zprev[q] = z[q];
                float ov; SCAN_STEP(S[q], r4[q], w4[q], k4[q], a4[q], b4[q], vi, ov);
                if (cq == 0 && ok[q]) aO[(size_t)row * 1024 + hh[q] * 64 + irow[q]] = ov; } }
#pragma unroll
        for (int q = 0; q < 2; ++q) if (ok[q]) *(f32x4*)(outp + OUT_RWS + ((size_t)((ss[q] * 16 + hh[q]) * 64 + irow[q])) * 64 + cq * 4) = S[q];
    }
}
constexpr int SS_SPLIT = 12288;


template <class Epi, int NSL>
__device__ __forceinline__ void gemm_fixup(const Epi& E, const pg8::Unit& u, const pg8::f32x4* p, int am, int wave, int lane) {
    const int ai = am >> 2, m = am & 3;
    pg8::f32x4 a[2][2];
#pragma unroll
    for (int bj = 0; bj < 2; ++bj)
#pragma unroll
        for (int n = 0; n < 2; ++n) { const int r = ((ai * 2 + bj) * 4 + m) * 2 + n; pg8::f32x4 v = p[(size_t)r * 512];
#pragma unroll
            for (int s = 1; s < NSL; ++s) v += p[((size_t)s * 32 + r) * 512];
            a[bj][n] = v; }
    E.row(a, ai, m, u, wave >> 2, wave & 3, lane & 15, lane >> 4);
}
#define GEMM_SPLIT(EPI_T, g_, Nn, E_, NSL_, KS_) do { \
    pg8::StaticOrder S_; S_.init(MPAD, (Nn), G, (int)blockIdx.x); const int nfull_ = (S_.nwg / G) * G, ntail_ = S_.nwg - nfull_; S_.limit = nfull_; \
    pg8::gemm_phase<EPI_T, pg8::StaticOrder, true, true>(L, g_, S_, E_); \
    if (ntail_ > 0) { \
        pg8::SplitOrder SS_{S_, nfull_, ntail_, (NSL_)}; pg8::Gemm gs_ = g_; gs_.K = (KS_); pg8::EpiPartial EP_{(float*)(ws + WS_PART)}; \
        pg8::gemm_phase<pg8::EpiPartial, pg8::SplitOrder, true, true>(L, gs_, SS_, EP_); \
        xcd_barrier(bar); \
        for (int it_ = blockIdx.x; it_ < ntail_ * 8; it_ += G) { const int j_ = it_ >> 3; pg8::Unit u_; S_.map(nfull_ + j_, u_); gemm_fixup<EPI_T, (NSL_)>(E_, u_, (const pg8::f32x4*)(ws + WS_PART) + (size_t)j_ * (NSL_) * 32 * 512 + tid, it_ & 7, wave, lane); } } } while (0)
__global__ void __launch_bounds__(512, 2) fwd(Args args) {
    extern __shared__ __attribute__((aligned(16))) unsigned char lds_raw[];
    LAS unsigned char* L = (LAS unsigned char*)lds_raw;
    const int tid = threadIdx.x, lane = tid & 63, wave = __builtin_amdgcn_readfirstlane(tid >> 6);
    const int G = gridDim.x;
#define gw ((int)blockIdx.x * 8 + wave)
#define NGW (G * 8)
#define gt ((int)blockIdx.x * 512 + tid)
#define NGT (G * 512)
    unsigned char* ws = args.ws;
    const int lo = args.ph_lo, hi = args.ph_hi;
    if (tid < 32) ((LAS unsigned*)(L + MISC_OFF))[tid] = 0u;
    __syncthreads();
    XcdBarrier bar = xcd_barrier_post((unsigned*)ws + 1024, (volatile LAS unsigned*)(L + MISC_OFF) + 8);
    if (hi > 1000) cg::this_grid().sync();
#ifndef PHMASK
#define PHMASK 0x3ff
#endif
#define IN(k) (((PHMASK >> (k)) & 1) && lo <= (k) && (k) < hi)
#define SEAM(k) do { if (IN(k) && IN((k) + 1)) { xcd_barrier(bar); } } while (0)

    if (IN(0)) {
        LAS float* scr = (LAS float*)(L + wave * 16384);
        constexpr int I_IN = 32 * 233, I_OUT = 32 * 64;
        for (int it = gw; it < I_IN + I_OUT; it += NGW) {
            if (it < I_IN) transpose_item(w_in, 2048, 7456, WT_IN, 1, scr, it, lane);
            else transpose_item(w_out, 2048, 2048, WT_OUT, 0, scr, it - I_IN, lane);
        }
        for (int i = gt; i < 224 * 256; i += NGT) *(v4u*)(WT_IN + (size_t)RC * 2048 + (size_t)i * 8) = (v4u){0u, 0u, 0u, 0u};
        for (int idx = gt; idx < 1024 * 288; idx += NGT) { const int c = idx / 288, i = idx - c * 288;
            const float v = i < 64 ? w2[(size_t)i * 1024 + c] : (i < 128 ? a2[(size_t)(i - 64) * 1024 + c] : g2[(size_t)(i - 128) * 1024 + c]);
            ((bf16*)(ws + WS_LT))[idx] = (bf16)f2bf(v); }
        for (int idx = gt; idx < NTP * 128; idx += NGT) {
            const int tp = idx >> 7, i = idx & 127;
            const double pos = tp < TP ? (double)tp : (double)(16384 + tp - TP);
            double invf = 1.0; for (int k = 0; k < i; ++k) invf *= 0.9300449458481391;
            const double ang = pos * invf;
            const double n = __builtin_rint(ang * 0.15915494309189535);
            double r = __builtin_fma(-n, 6.283185307179586, ang); r = __builtin_fma(-n, 2.4492935982947064e-16, r);
            const double r2 = r * r; double sn = r, cn = 1.0, ts = r, tc = 1.0;
            for (int k = 1; k <= 15; ++k) { tc *= -r2 / (double)((2 * k - 1) * (2 * k)); ts *= -r2 / (double)((2 * k) * (2 * k + 1)); cn += tc; sn += ts; }
            CS[(size_t)idx * 2] = (float)cn; CS[(size_t)idx * 2 + 1] = (float)sn;
        }
        for (int m = gw; m < MPAD; m += 2 * NGW) { const int m1 = m + NGW;
            if (m1 < MR) rms_rows2_bf16(pg8::xsrc_row(x_prompt, x_sample, meta, m), pg8::xsrc_row(x_prompt, x_sample, meta, m1), norm_mix, XN + (size_t)m * DM, XN + (size_t)m1 * DM, lane);
            else { if (m < MR) rms_row_bf16(pg8::xsrc_row(x_prompt, x_sample, meta, m), norm_mix, XN + (size_t)m * DM, lane); else zero_row_bf16(XN + (size_t)m * DM, lane);
                   if (m1 < MPAD) zero_row_bf16(XN + (size_t)m1 * DM, lane); }
        }
    }
    SEAM(0);
    if (IN(1)) {
        pg8::Gemm g{XN, WT_IN, MPAD, NIN, DM, DM};
        pg8::EpiIn E{ZA, ZB, CS};
        GEMM_SPLIT(pg8::EpiIn, g, NIN, E, 8, 256);
    }
    SEAM(1);
    if (IN(2)) {
        LAS unsigned char* X = L;
        const bf16* LT = (const bf16*)(ws + WS_LT);
        const int fr = lane & 15, fq = lane >> 4;
        if (args.sub & 1)
        for (int grp = blockIdx.x; grp < MR / 16; grp += G) {
            const int row0 = grp * 16;
            { float zv[9], zpv[9], muv[9]; int tidv = tid; asm volatile("" : "+v"(tidv));
#pragma unroll
            for (int it = 0; it < 9; ++it) { const int idx = tidv + 512 * it, t = idx / 288, i = idx - t * 288, row = row0 + t, col = 3072 + i;
                zv[it] = ZA[(size_t)row * RC + col]; zpv[it] = zprev_val(ZA, state_shift, row, col); muv[it] = mu[col]; }
#pragma unroll
            for (int it = 0; it < 9; ++it) { const int idx = tidv + 512 * it, t = idx / 288, i = idx - t * 288;
                const float zs = zv[it] + muv[it] * (zpv[it] - zv[it]);
                const float val = i < 64 ? ftanh(zs) : (i < 128 ? zs : fsig(zs));
                *(LAS unsigned short*)(X + t * 592 + i * 2) = (unsigned short)f2bf(val); } }
            __syncthreads();
            const int row = row0 + fr;
            const float* zrow = ZA + (size_t)row * RC; const float* pz;
            if (row < MP) pz = (row % TP) == 0 ? nullptr : zrow - RC;
            else { const int rr = row - MP; pz = (rr & 3) == 0 ? state_shift + (size_t)(rr >> 2) * RC : zrow - RC; }
#pragma unroll 1
            for (int hd = (args.sub & 64) ? 2 : 0; hd < 2; ++hd) { const int head = 2 * wave + hd;
                bf16x8 xf[9];
#pragma unroll
                for (int ks = 0; ks < 9; ++ks) xf[ks] = *(const LAS bf16x8*)(X + fr * 592 + (ks * 32 + 8 * fq) * 2);
                f32x4 aw[4], aa[4], ag[4];
#pragma unroll
                for (int t = 0; t < 4; ++t) { const bf16* wt = LT + (size_t)(head * 64 + 16 * t + fr) * 288 + 8 * fq;
                    aw[t] = (f32x4){0.f, 0.f, 0.f, 0.f}; aa[t] = aw[t]; ag[t] = aw[t];
#pragma unroll
                    for (int ks = 0; ks < 2; ++ks) aw[t] = __builtin_amdgcn_mfma_f32_16x16x32_bf16(*(const bf16x8*)(wt + ks * 32), xf[ks], aw[t], 0, 0, 0);
#pragma unroll
                    for (int ks = 0; ks < 2; ++ks) aa[t] = __builtin_amdgcn_mfma_f32_16x16x32_bf16(*(const bf16x8*)(wt + 64 + ks * 32), xf[2 + ks], aa[t], 0, 0, 0);
#pragma unroll
                    for (int ks = 0; ks < 5; ++ks) ag[t] = __builtin_amdgcn_mfma_f32_16x16x32_bf16(*(const bf16x8*)(wt + 128 + ks * 32), xf[4 + ks], ag[t], 0, 0, 0);
                    if (t == 1) asm volatile("" ::: "memory"); }
                if (args.sub & 32) {
#pragma unroll
                    for (int t = 0; t < 4; ++t) asm volatile("" :: "v"(aw[t]), "v"(aa[t]), "v"(ag[t]));
                    continue; }
                f32x4 kk4[4], av4[4], r4[4], dec4[4], k24[4]; float ssq = 0.f, bon = 0.f;
#pragma unroll
                for (int t = 0; t < 4; ++t) { const int c = head * 64 + 16 * t + 4 * fq;
                    const f32x4 zr = *(const f32x4*)(zrow + c), zk = *(const f32x4*)(zrow + 1024 + c);
                    f32x4 pr = (f32x4){0.f, 0.f, 0.f, 0.f}, pk = pr;
                    if (pz) { pr = *(const f32x4*)(pz + c); pk = *(const f32x4*)(pz + 1024 + c); }
                    const f32x4 r = zr + *(const f32x4*)(mu + c) * (pr - zr), k = zk + *(const f32x4*)(mu + 1024 + c) * (pk - zk);
                    const f32x4 w0v = *(const f32x4*)(w0 + c), a0v = *(const f32x4*)(a0 + c), kkv = *(const f32x4*)(k_k + c), kav = *(const f32x4*)(k_a + c), rkv = *(const f32x4*)(r_k + c);
                    r4[t] = r;
                    if (t == 2) {
#pragma unroll
                        for (int t2 = 0; t2 < 2; ++t2) { const size_t o2 = (size_t)row * 1024 + head * 64 + 16 * t2 + 4 * fq;
                            *(f32x4*)(aW + o2) = dec4[t2]; *(f32x4*)(aG + o2) = ag[t2]; } }
#pragma unroll
                    for (int q = 0; q < 4; ++q) { const float xx = -(w0v[q] + aw[t][q]);
                        const float sp = fmaxf(xx, 0.f) + __logf(1.0f + fexp(-fabsf(xx))); dec4[t][q] = fexp(-fexp(-sp - 0.5f));
                        av4[t][q] = fsig(a0v[q] + aa[t][q]); kk4[t][q] = k[q] * kkv[q]; k24[t][q] = k[q] * (1.0f + (av4[t][q] - 1.0f) * kav[q]);
                        ssq += kk4[t][q] * kk4[t][q]; bon += r[q] * k24[t][q] * rkv[q]; }
                    if (t == 1) asm volatile("" ::: "memory"); }
                ssq += __shfl_xor(ssq, 16); ssq += __shfl_xor(ssq, 32); bon += __shfl_xor(bon, 16); bon += __shfl_xor(bon, 32);
                const float inv = 1.0f / fmaxf(sqrtf(ssq), 1e-12f);
#pragma unroll
                for (int t = 0; t < 4; ++t) { const size_t o = (size_t)row * 1024 + head * 64 + 16 * t + 4 * fq;
                    const f32x4 kk = kk4[t] * inv, na = -kk, nb = kk * av4[t];
                    v4u X_, Y_; X_.x = pk2(r4[t].x, k24[t].x); X_.y = pk2(na.x, nb.x); X_.z = pk2(r4[t].y, k24[t].y); X_.w = pk2(na.y, nb.y);
                    Y_.x = pk2(r4[t].z, k24[t].z); Y_.y = pk2(na.z, nb.z); Y_.z = pk2(r4[t].w, k24[t].w); Y_.w = pk2(na.w, nb.w);
                    *(v4u*)(RKAB + o * 4) = X_; *(v4u*)(RKAB + o * 4 + 8) = Y_;
                    if (t >= 2) { *(f32x4*)(aW + o) = dec4[t]; *(f32x4*)(aG + o) = ag[t]; } }
                if (fq == 0) BON[(size_t)row * 16 + head] = bon;
            }
            __syncthreads();
        }
        { const int ngrp = MR / 16, rounds = (ngrp + G - 1) / G, nheavy = ngrp - (rounds - 1) * G;
          const int nlightb = G - nheavy;
          if (nlightb > 0 && (int)blockIdx.x >= nheavy) {
            LAS float* scr = (LAS float*)(L + wave * 16384);
            constexpr int I_G = 32 * 176, I_D = 88 * 64;
            for (int it = ((int)blockIdx.x - nheavy) * 8 + wave; it < 2 * I_G + I_D; it += nlightb * 8) {
                if (it < I_G) transpose_item(w_gate, 2048, DFF, WT_GU, 2, scr, it, lane);
                else if (it < 2 * I_G) transpose_item(w_up, 2048, DFF, WT_GU, 3, scr, it - I_G, lane);
                else transpose_item(w_down, DFF, 2048, WT_DN, 0, scr, it - 2 * I_G, lane);
            } } }
    }
    SEAM(2);
    if (IN(3)) {
        const int GH = G >> 1;
        if ((int)blockIdx.x >= GH) {
            const int bx = blockIdx.x - GH, GR = G - GH;
            if (args.sub & 2)
            for (int u = bx; u < 128; u += GR) ret_prompt_unit(L, ZB, ORET, out + OUT_RTP, u, tid);
            if (args.sub & 4)
            for (int u = bx; u < 512; u += GR) ret_sample_unit(L, ZB, state_ret, out + OUT_RTS, OAB, u, tid);
            if (args.sub & 16) sample_scan_units(ws, state_rwkv, state_shift, mu, out, SS_SPLIT + bx * 8 + wave, NS * 16 * 16, GR * 8, lane);
        } else {
        LAS float* buf = (LAS float*)L;
        LAS float* vbuf = buf + 2 * 16 * 320;
        const int ri = lane >> 4, cq = lane & 15;
        if (args.sub & 8)
        for (int u = blockIdx.x; u < 128; u += GH) {
            const int b = u >> 5, h = (u >> 1) & 15, hf = u & 1;
            const int rowb = b * TP;
            f32x4 S = (f32x4){0.f, 0.f, 0.f, 0.f};
            const int irow = hf * 32 + wave * 4 + ri;
            f32x4 prew[2]; v4u prex[2], prey[2]; float prevz[2], prevp[2];
            const bool l_last = tid < 256;
            const int l_st = (tid >> 4) & 15, l_c4 = tid & 15, l_off = l_st * 1024 + h * 64 + l_c4 * 4, l_lds = l_st * 320 + l_c4 * 4;
            const int v_st = tid >> 5, v_rr = tid & 31, v_col = 2048 + h * 64 + hf * 32 + v_rr;
            const float v_mu = mu[v_col];
            float keep = 0.f;
#define SCAN_LOAD(c, s_) do { const size_t rb_ = (size_t)(rowb + (c) * 16); \
            if (l_last) { prew[s_] = *(const f32x4*)(aW + rb_ * 1024 + l_off); prex[s_] = *(const v4u*)(RKAB + (rb_ * 1024 + l_off) * 4); prey[s_] = *(const v4u*)(RKAB + (rb_ * 1024 + l_off) * 4 + 8); } \
            { const int p_ = (c) * 16 + v_st; prevz[s_] = ZA[(size_t)(rowb + p_) * RC + v_col]; prevp[s_] = p_ == 0 ? 0.f : ZA[(size_t)(rowb + p_ - 1) * RC + v_col]; } } while (0)
#define SCAN_STORE(bb, s_) do { \
            if (l_last) { f32x4 r_, k_, a_, b_; rkab_unpack(prex[s_], prey[s_], r_, k_, a_, b_); LAS float* d_ = buf + (bb) * 5120 + l_lds; \
                *(LAS f32x4*)d_ = r_; *(LAS f32x4*)(d_ + 64) = prew[s_]; *(LAS f32x4*)(d_ + 128) = k_; *(LAS f32x4*)(d_ + 192) = a_; *(LAS f32x4*)(d_ + 256) = b_; } \
            vbuf[(bb) * 512 + v_st * 32 + v_rr] = prevz[s_] + v_mu * (prevp[s_] - prevz[s_]); } while (0)
#define SCAN_ITER(k) do { const int c = c0 + (k); if (c < 129) { \
                { const LAS float* bb = buf + ((k) & 1) * 5120; const LAS float* vb = vbuf + ((k) & 1) * 512; \
                    _Pragma("unroll 4") for (int st = 0; st < 16; ++st) { \
                        const f32x4 r4 = *(const LAS f32x4*)(bb + st * 320 + 0 * 64 + cq * 4), w4 = *(const LAS f32x4*)(bb + st * 320 + 1 * 64 + cq * 4), k4 = *(const LAS f32x4*)(bb + st * 320 + 2 * 64 + cq * 4); \
                        const f32x4 a4 = *(const LAS f32x4*)(bb + st * 320 + 3 * 64 + cq * 4), b4 = *(const LAS f32x4*)(bb + st * 320 + 4 * 64 + cq * 4); \
                        const float vi = vb[st * 32 + wave * 4 + ri]; \
                        float ov; SCAN_STEP(S, r4, w4, k4, a4, b4, vi, ov); \
                        keep = cq == st ? ov : keep; \
                    } } \
                if (c + 1 < 129) SCAN_STORE(((k) + 1) & 1, ((k) + 1) & 1); \
                if (c + 3 < 129) SCAN_LOAD(c + 3, ((k) + 1) & 1); \
                aO[(size_t)(rowb + c * 16 + cq) * 1024 + h * 64 + irow] = keep; \
                __syncthreads(); } } while (0)
            SCAN_LOAD(0, 0); SCAN_LOAD(1, 1); SCAN_STORE(0, 0); SCAN_LOAD(2, 0);
            __syncthreads();
            for (int c0 = 0; c0 < 129; c0 += 2) { SCAN_ITER(0); SCAN_ITER(1); }
            *(f32x4*)(out + OUT_RWP + ((size_t)((b * 16 + h) * 64 + irow)) * 64 + cq * 4) = S;
            __syncthreads();
        }
#undef SCAN_LOAD
#undef SCAN_STORE
#undef SCAN_ITER
        if (args.sub & 16) sample_scan_units(ws, state_rwkv, state_shift, mu, out, gw, SS_SPLIT, GH * 8, lane);
        }
    }
    SEAM(3);
    if (IN(4)) {
        for (int wu = gw; wu < MR * 4; wu += NGW) {
            const int row = wu >> 2, c = (wu & 3) * 256 + 4 * lane, head = c >> 6;
            const f32x4 o = *(const f32x4*)(aO + (size_t)row * 1024 + c);
            const float* zr = ZA + (size_t)row * RC + 2048 + c; const f32x4 z = *(const f32x4*)zr; f32x4 zp = (f32x4){0.f, 0.f, 0.f, 0.f};
            if (row < MP) { if ((row % TP) != 0) zp = *(const f32x4*)(zr - RC); }
            else { const int rr = row - MP; zp = (rr & 3) == 0 ? *(const f32x4*)(state_shift + (size_t)(rr >> 2) * RC + 2048 + c) : *(const f32x4*)(zr - RC); }
            const f32x4 muv = *(const f32x4*)(mu + 2048 + c), lw = *(const f32x4*)(ln_w + c), lb = *(const f32x4*)(ln_b + c), g = *(const f32x4*)(aG + (size_t)row * 1024 + c);
            const float bon = BON[(size_t)row * 16 + head];
            const float mean = rowsum16((o.x + o.y) + (o.z + o.w)) * (1.0f / 64.0f);
            const f32x4 d = o - mean;
            const float var = rowsum16((d.x * d.x + d.y * d.y) + (d.z * d.z + d.w * d.w)) * (1.0f / 64.0f);
            const float rs = 1.0f / sqrtf(var + 64e-5f);
            const f32x4 v = z + muv * (zp - z);
            const f32x4 res = (d * rs * lw + lb + v * bon) * g;
            v2u w; w.x = pk2(res.x, res.y); w.y = pk2(res.z, res.w);
            *(v2u*)(OAB + (size_t)row * 2048 + c) = w;
        }
        for (int wu = gw; wu < MP * 4; wu += NGW) {
            const int row = wu >> 2, h = wu & 3, c = h * 256 + 4 * lane;
            const f32x4 o = *(const f32x4*)(ORET + (size_t)row * 1024 + c);
            const float ss = wave_sum((o.x * o.x + o.y * o.y) + (o.z * o.z + o.w * o.w));
            const float rs = 1.0f / sqrtf(ss * (1.0f / 256.0f) + 1e-6f);
            const v2u gb = *(const v2u*)(ZB + (size_t)row * 4096 + 3072 + c);
            const float g0 = bf2f(gb.x & 0xffffu), g1 = bf2f(gb.x >> 16), g2_ = bf2f(gb.y & 0xffffu), g3 = bf2f(gb.y >> 16);
            v2u w; w.x = pk2(o.x * rs * (g0 / (1.0f + expf(-g0))), o.y * rs * (g1 / (1.0f + expf(-g1)))); w.y = pk2(o.z * rs * (g2_ / (1.0f + expf(-g2_))), o.w * rs * (g3 / (1.0f + expf(-g3))));
            *(v2u*)(OAB + (size_t)row * 2048 + 1024 + c) = w;
        }
        for (int i = gt; i < (NB + NS) * RC; i += NGT) { const int sq = i / RC, col = i - sq * RC;
            if (sq < NB) out[OUT_SHP + (size_t)sq * RC + col] = ZA[(size_t)(sq * TP + TP - 1) * RC + col];
            else out[OUT_SHS + (size_t)(sq - NB) * RC + col] = ZA[(size_t)(MP + 4 * (sq - NB) + 3) * RC + col]; }
    }
    SEAM(4);
    if (IN(5)) {
        pg8::Gemm g{OAB, WT_OUT, MPAD, DM, DM, DM};
        pg8::EpiOut E{H, x_prompt, x_sample, meta};
        GEMM_SPLIT(pg8::EpiOut, g, DM, E, 8, 256);
    }
    SEAM(5);
    if (IN(6)) {
        for (int m = gw; m < MPAD; m += 2 * NGW) { const int m1 = m + NGW;
            if (m1 < MR) rms_rows2_bf16(H + (size_t)m * DM, H + (size_t)m1 * DM, norm_ffn, XN + (size_t)m * DM, XN + (size_t)m1 * DM, lane);
            else { if (m < MR) rms_row_bf16(H + (size_t)m * DM, norm_ffn, XN + (size_t)m * DM, lane); else zero_row_bf16(XN + (size_t)m * DM, lane);
                   if (m1 < MPAD) zero_row_bf16(XN + (size_t)m1 * DM, lane); }
        }
    }
    SEAM(6);
    if (IN(7)) {
        pg8::Gemm g{XN, WT_GU, MPAD, 2 * DFF, DM, DM};
        pg8::EpiGateUp E{ACT};
        GEMM_SPLIT(pg8::EpiGateUp, g, 2 * DFF, E, 8, 256);
    }
    SEAM(7);
    if (IN(8)) {
        pg8::Gemm g{ACT, WT_DN, MPAD, DM, DFF, DFF};
        pg8::EpiDown E{H};
        GEMM_SPLIT(pg8::EpiDown, g, DM, E, 4, 1408);
    }
    SEAM(8);
    if (IN(9)) {
        for (int m = gw; m < MR; m += NGW) {
            float* dst;
            if (m < MP) { const int b = m / TP, p = m - b * TP; if (p < 16) continue; dst = out + OUT_YP + ((size_t)b * SEQ + (p - 16)) * DM; }
            else dst = out + OUT_YS + (size_t)(m - MP) * DM;
            const float* xr = H + (size_t)m * DM;
            f32x4 v[8]; float s = 0.f;
#pragma unroll
            for (int j = 0; j < 8; ++j) { v[j] = *(const f32x4*)(xr + 4 * lane + 256 * j); s += (v[j].x * v[j].x + v[j].y * v[j].y) + (v[j].z * v[j].z + v[j].w * v[j].w); }
            const float rs = 1.0f / sqrtf(wave_sum(s) * (1.0f / 2048.0f) + 1e-6f);
#pragma unroll
            for (int j = 0; j < 8; ++j) { const f32x4 g = *(const f32x4*)(norm_final + 4 * lane + 256 * j); *(f32x4*)(dst + 4 * lane + 256 * j) = v[j] * rs * g; }
        }
    }
#undef IN
#undef SEAM
#undef gw
#undef NGW
#undef gt
#undef NGT
}

#undef x_prompt
#undef x_sample
#undef state_shift
#undef state_rwkv
#undef state_ret
#undef meta
#undef norm_mix
#undef w_in
#undef mu
#undef w0
#undef w2
#undef a0
#undef a2
#undef g2
#undef k_k
#undef k_a
#undef r_k
#undef ln_w
#undef ln_b
#undef w_out
#undef norm_ffn
#undef w_gate
#undef w_up
#undef w_down
#undef norm_final
#undef out
#undef CS
#undef BON
#undef WT_IN
#undef WT_OUT
#undef WT_GU
#undef WT_DN
#undef XN
#undef OAB
#undef ZA
#undef ZB
#undef RKAB
#undef aW
#undef aG
#undef aO
#undef ORET
#undef H
#undef ACT
#undef IN_
#ifndef MK_MULTI
#define MK_MULTI 0
#endif
extern "C" void kernel_launch(void* const* d_in, const int* in_sizes, int n_in, void* d_out, int out_size, void* d_ws, size_t ws_size, hipStream_t stream) {
    static int grid = 0;
    if (grid == 0) {
        int dev = 0, cus = 0, per_cu = 0;
        (void)hipGetDevice(&dev);
        (void)hipDeviceGetAttribute(&cus, hipDeviceAttributeMultiprocessorCount, dev);
        (void)hipFuncSetAttribute((const void*)fwd, hipFuncAttributeMaxDynamicSharedMemorySize, LDS_BYTES);
        if (hipOccupancyMaxActiveBlocksPerMultiprocessor(&per_cu, (const void*)fwd, 512, LDS_BYTES) != hipSuccess || per_cu < 1) per_cu = 1;
        (void)hipGetLastError();
        if (per_cu > 1) per_cu = 1;
        grid = cus > 0 ? cus * per_cu : 256;
        if (ws_size < WS_END) fprintf(stderr, "kernel_launch: workspace too small: %zu < %zu\n", ws_size, (size_t)WS_END);
    }
    (void)hipMemsetAsync(d_ws, 0, 65536, stream);
    Args a{};
    for (int i = 0; i < 25; ++i) a.in[i] = (const float*)d_in[i];
    a.out = (float*)d_out; a.ws = (unsigned char*)d_ws; a.sub = 31;
#if MK_MULTI
#ifndef REPEAT_MASK
#define REPEAT_MASK 0
#endif
#ifndef REPEAT_SUB
#define REPEAT_SUB 7
#endif
    for (int ph = 0; ph < NPH; ++ph) for (int rep = 0; rep < 1 + ((REPEAT_MASK >> ph) & 1); ++rep) { a.ph_lo = ph; a.ph_hi = ph + 1; a.sub = rep ? REPEAT_SUB : 31; (void)hipMemsetAsync(d_ws, 0, 65536, stream); hipLaunchKernelGGL(fwd, dim3(grid), dim3(512), LDS_BYTES, stream, a); }
#else
    a.ph_lo = 0; a.ph_hi = NPH;
    void* kargs[] = {&a};
    hipError_t e = hipLaunchCooperativeKernel((const void*)fwd, dim3(grid), dim3(512), kargs, LDS_BYTES, stream);
    if (e != hipSuccess) fprintf(stderr, "cooperative launch failed: %s (grid %d)\n", hipGetErrorString(e), grid);
#endif
}
```

```cpp
#define MK_MULTI 0
#include <hip/hip_runtime.h>
#include <hip/hip_cooperative_groups.h>
#include <cstdio>
#include <cstdint>
namespace cg = cooperative_groups;
namespace pg8 {
#define PG8_LAS __attribute__((address_space(3)))
typedef unsigned short bf16_t;
typedef short bf16x8 __attribute__((ext_vector_type(8)));
typedef float f32x4 __attribute__((ext_vector_type(4)));
typedef unsigned u32x4 __attribute__((ext_vector_type(4)));
constexpr int BM = 256, BK = 64, HALF = 128, HTB = HALF * BK * 2  , STAGE_BYTES = 8 * HTB, NXCD = 8, WGM = 4;

__host__ __device__ __forceinline__ int lds_byte(int r, int c) { const int st = (r >> 4) * 2 + (c >> 5), rr = r & 15, cc = c & 31, ob = rr * 64 + cc * 2; return st * 1024 + (ob ^ (((ob >> 9) & 1) << 5)); }
__host__ __device__ __forceinline__ void stage_rc(int b, int& R, int& C) { const int st = b / 1024, sb = b % 1024, swz = sb ^ (((sb >> 9) & 1) << 5); R = (st >> 1) * 16 + swz / 64; C = (st & 1) * 32 + (swz % 64) / 2; }
__host__ __device__ __forceinline__ int perm32(int rho) { const int n = rho >> 4, i = rho & 15; return 8 * (i >> 2) + 4 * n + (i & 3); }

struct Unit { int pm, pn, ks, aux; };
struct Gemm { const bf16_t* A; const bf16_t* Bt; int M, N, K, ld; };

struct StaticOrder {
    int nM, nN, nwg, G, c, limit;
    __host__ __device__ void init(int M, int N, int G_, int c_) { nM = M / BM; nN = N / BM; nwg = nM * nN; G = G_; c = c_; limit = nwg; }
    __host__ __device__ __forceinline__ bool next(int i, Unit& u) const {
        const long L = (long)i * G + c; if (L >= limit) return false;
        return map((int)L, u);
    }
    __host__ __device__ __forceinline__ bool map(int L, Unit& u) const {
        int wgid = L; u.ks = 0; u.aux = 0; { const int q = nwg / NXCD, r = nwg % NXCD, xcd = wgid % NXCD, off = wgid / NXCD; wgid = (xcd < r ? xcd * (q + 1) : r * (q + 1) + (xcd - r) * q) + off; }
        const int nig = WGM * nN, gid = wgid / nig, fm = gid * WGM, gsz = (nM - fm) < WGM ? (nM - fm) : WGM;
        u.pm = fm + ((wgid % nig) % gsz); u.pn = (wgid % nig) / gsz; return true;
    }
    __device__ __forceinline__ void a_ready(const Unit&) const {}
    __device__ __forceinline__ void done(const Unit&) const {}
};


__device__ __forceinline__ unsigned cvt_pk_bf16(float lo, float hi) { unsigned r; asm volatile("v_cvt_pk_bf16_f32 %0, %1, %2" : "=v"(r) : "v"(lo), "v"(hi)); return r; }

constexpr int E_MP = 8256, E_MR = 8768, E_TP = 2064, E_RC = 3360;

#define EPI_WALK() \
    __device__ __forceinline__ void operator()(const f32x4 (&acc)[2][2][4][2], const Unit& u, int wr, int wc, int fr, int fq) const { \
        _Pragma("unroll") for (int ai = 0; ai < 2; ++ai) _Pragma("unroll") for (int m = 0; m < 4; ++m) { \
            f32x4 a[2][2]; a[0][0] = acc[ai][0][m][0]; a[0][1] = acc[ai][0][m][1]; a[1][0] = acc[ai][1][m][0]; a[1][1] = acc[ai][1][m][1]; row(a, ai, m, u, wr, wc, fr, fq); } }

struct EpiIn {
    static constexpr bool PERM = true, AFTER_DRAIN = false;
    float* ZA; bf16_t* ZB; const float* CS;
    __device__ __forceinline__ void row(const f32x4 (&a)[2][2], int ai, int m, const Unit& u, int wr, int wc, int fr, int fq) const {
        const int row = u.pm * BM + wr * 64 + fr + ai * HALF + m * 16;
        if (u.pn < 14) {
#pragma unroll
            for (int bj = 0; bj < 2; ++bj) { const int col = u.pn * BM + bj * HALF + wc * 32 + 8 * fq;
                if (col < E_RC) { float* p = ZA + (size_t)row * E_RC + col; *(f32x4*)p = a[bj][0]; *(f32x4*)(p + 4) = a[bj][1]; } }
        } else {
            const int ct = (u.pn - 14) * BM;
            const int tp = row < E_MP ? row % E_TP : (row < E_MR ? E_TP + ((row - E_MP) & 3) : 0);
#pragma unroll
            for (int bj = 0; bj < 2; ++bj) { const int c = ct + bj * HALF + wc * 32 + 8 * fq;
                f32x4 v0 = a[bj][0], v1 = a[bj][1];
                if (c < 2048) {
                    const float* cs = CS + ((size_t)tp * 128 + ((c & 255) >> 1)) * 2;
                    const f32x4 t0 = *(const f32x4*)cs, t1 = *(const f32x4*)(cs + 4);
                    const float sc = c >= 1024 ? 0.0625f : 1.0f;
                    f32x4 w0, w1;
                    w0[0] = (v0[0] * t0[0] - v0[1] * t0[1]) * sc; w0[1] = (v0[0] * t0[1] + v0[1] * t0[0]) * sc;
                    w0[2] = (v0[2] * t0[2] - v0[3] * t0[3]) * sc; w0[3] = (v0[2] * t0[3] + v0[3] * t0[2]) * sc;
                    w1[0] = (v1[0] * t1[0] - v1[1] * t1[1]) * sc; w1[1] = (v1[0] * t1[1] + v1[1] * t1[0]) * sc;
                    w1[2] = (v1[2] * t1[2] - v1[3] * t1[3]) * sc; w1[3] = (v1[2] * t1[3] + v1[3] * t1[2]) * sc;
                    v0 = w0; v1 = w1;
                }
                u32x4 w; w.x = cvt_pk_bf16(v0[0], v0[1]); w.y = cvt_pk_bf16(v0[2], v0[3]); w.z = cvt_pk_bf16(v1[0], v1[1]); w.w = cvt_pk_bf16(v1[2], v1[3]);
                *(u32x4*)(ZB + (size_t)row * 4096 + c) = w; }
        }
    }
    EPI_WALK()
};

__device__ __forceinline__ const float* xsrc_row(const float* xp, const float* xs, const float* meta, int row) {
    if (row < E_MP) { const int b = row / E_TP, p = row - b * E_TP; return p < 16 ? meta + (size_t)p * 2048 : xp + ((size_t)b * 2048 + (p - 16)) * 2048; }
    if (row < E_MR) return xs + (size_t)(row - E_MP) * 2048;
    return nullptr;
}

struct EpiOut {
    static constexpr bool PERM = true, AFTER_DRAIN = false;
    float* H; const float* xp; const float* xs; const float* meta;
    __device__ __forceinline__ void row(const f32x4 (&a)[2][2], int ai, int m, const Unit& u, int wr, int wc, int fr, int fq) const {
        const int row = u.pm * BM + wr * 64 + fr + ai * HALF + m * 16; const float* xr = xsrc_row(xp, xs, meta, row);
#pragma unroll
        for (int bj = 0; bj < 2; ++bj) { const int col = u.pn * BM + bj * HALF + wc * 32 + 8 * fq;
            f32x4 v0 = a[bj][0], v1 = a[bj][1];
            if (xr) { v0 += *(const f32x4*)(xr + col); v1 += *(const f32x4*)(xr + col + 4); }
            float* p = H + (size_t)row * 2048 + col; *(f32x4*)p = v0; *(f32x4*)(p + 4) = v1; }
    }
    EPI_WALK()
};

__device__ __forceinline__ float silu_f(float x) { return x / (1.0f + __expf(-x)); }

struct EpiGateUp {
    static constexpr bool PERM = true, AFTER_DRAIN = false;
    bf16_t* ACT;
    __device__ __forceinline__ void row(const f32x4 (&a)[2][2], int ai, int m, const Unit& u, int wr, int wc, int fr, int fq) const {
        const int row = u.pm * BM + wr * 64 + fr + ai * HALF + m * 16; const int col = u.pn * HALF + wc * 32 + 8 * fq;
        const f32x4 g0 = a[0][0], g1 = a[0][1], u0 = a[1][0], u1 = a[1][1];
        u32x4 w;
        w.x = cvt_pk_bf16(silu_f(g0[0]) * u0[0], silu_f(g0[1]) * u0[1]); w.y = cvt_pk_bf16(silu_f(g0[2]) * u0[2], silu_f(g0[3]) * u0[3]);
        w.z = cvt_pk_bf16(silu_f(g1[0]) * u1[0], silu_f(g1[1]) * u1[1]); w.w = cvt_pk_bf16(silu_f(g1[2]) * u1[2], silu_f(g1[3]) * u1[3]);
        *(u32x4*)(ACT + (size_t)row * 5632 + col) = w;
    }
    EPI_WALK()
};

struct EpiDown {
    static constexpr bool PERM = true, AFTER_DRAIN = false;
    float* H;
    __device__ __forceinline__ void row(const f32x4 (&a)[2][2], int ai, int m, const Unit& u, int wr, int wc, int fr, int fq) const {
        const int row = u.pm * BM + wr * 64 + fr + ai * HALF + m * 16;
#pragma unroll
        for (int bj = 0; bj < 2; ++bj) { const int col = u.pn * BM + bj * HALF + wc * 32 + 8 * fq;
            float* p = H + (size_t)row * 2048 + col;
            const f32x4 v0 = *(const f32x4*)p + a[bj][0], v1 = *(const f32x4*)(p + 4) + a[bj][1];
            *(f32x4*)p = v0; *(f32x4*)(p + 4) = v1; }
    }
    EPI_WALK()
};

struct SplitOrder {
    StaticOrder so; int base, ntail, nsl;
    __device__ __forceinline__ bool next(int i, Unit& u) const { const int v = i * so.G + so.c; if (v >= ntail * nsl) return false; so.map(base + v / nsl, u); u.ks = v % nsl; u.aux = v; return true; }
    __device__ __forceinline__ void a_ready(const Unit&) const {}
    __device__ __forceinline__ void done(const Unit&) const {}
};
struct EpiPartial {
    static constexpr bool PERM = true, AFTER_DRAIN = false;
    float* P;
    __device__ __forceinline__ void operator()(const f32x4 (&acc)[2][2][4][2], const Unit& u, int wr, int wc, int fr, int fq) const {
        f32x4* p = (f32x4*)P + (size_t)u.aux * 32 * 512 + threadIdx.x;
#pragma unroll
        for (int ai = 0; ai < 2; ++ai)
#pragma unroll
            for (int bj = 0; bj < 2; ++bj)
#pragma unroll
                for (int m = 0; m < 4; ++m)
#pragma unroll
                    for (int n = 0; n < 2; ++n) p[(size_t)((((ai * 2 + bj) * 4 + m) * 2 + n)) * 512] = acc[ai][bj][m][n];
    }
};
template <class Epi, class Sched, bool ALIGN_EPI = false, bool SP2 = false>
__device__ __forceinline__ void gemm_phase(PG8_LAS unsigned char* lds, const Gemm g, const Sched& S, const Epi& E) {
    const int tid = threadIdx.x, wid = __builtin_amdgcn_readfirstlane(tid >> 6), lane = tid & 63, wr = wid >> 2, wc = wid & 3, fr = lane & 15, fq = lane >> 4;
    const int K = g.K, nt = K / BK, KL = g.ld;
    unsigned voffA[2], voffB[2];
#pragma unroll
    for (int i = 0; i < 2; ++i) { int R, C; stage_rc(tid * 16 + i * 8192, R, C); const int Rb = Epi::PERM ? ((R & ~31) + perm32(R & 31)) : R;
        voffA[i] = (unsigned)(R * KL + C) * 2u; voffB[i] = (unsigned)(Rb * KL + C) * 2u; }
    const size_t kstep = (size_t)(BK * 2);
    const size_t hstep = (size_t)HALF * KL * 2;
    const size_t tstep = 2 * hstep;
    const unsigned ldsw = (unsigned)wid * 1024u;
    const int aoff = lds_byte(wr * 64 + fr, fq * 8), boff = lds_byte(wc * 32 + fr, fq * 8);
#define PG8_SA(b, h) (((b) * 2 + (h)) * HTB)
#define PG8_SB(b, h) ((4 + (b) * 2 + (h)) * HTB)
#define PG8_STAGE(bufoff, gbase, voff) do { _Pragma("unroll") for (int _i = 0; _i < 2; ++_i) \
        __builtin_amdgcn_global_load_lds((const unsigned*)((const char*)(gbase) + (voff)[_i]), (PG8_LAS unsigned*)(lds + (bufoff) + ldsw + _i * 8192), 16, 0, 0); } while (0)
#define PG8_LDA(dst, b, h) do { _Pragma("unroll") for (int m = 0; m < 4; ++m) _Pragma("unroll") for (int k = 0; k < 2; ++k) dst[m][k] = *(const PG8_LAS bf16x8*)(lds + PG8_SA(b, h) + aoff + m * 2048 + k * 1024); } while (0)
#define PG8_LDB(dst, b, h) do { _Pragma("unroll") for (int n = 0; n < 2; ++n) _Pragma("unroll") for (int k = 0; k < 2; ++k) dst[n][k] = *(const PG8_LAS bf16x8*)(lds + PG8_SB(b, h) + boff + n * 2048 + k * 1024); } while (0)
#define PG8_MMA(ai, bj, At, Bt) do { __builtin_amdgcn_s_setprio(1); _Pragma("unroll") for (int m = 0; m < 4; ++m) _Pragma("unroll") for (int n = 0; n < 2; ++n) _Pragma("unroll") for (int k = 0; k < 2; ++k) \
        acc[ai][bj][m][n] = __builtin_amdgcn_mfma_f32_16x16x32_bf16(Bt[n][k], At[m][k], acc[ai][bj][m][n], 0, 0, 0); __builtin_amdgcn_s_setprio(0); } while (0)
#define PG8_WAIT_V(n) asm volatile("s_waitcnt vmcnt(" #n ")" ::: "memory")
#define PG8_WAIT_L(n) asm volatile("s_waitcnt lgkmcnt(" #n ")" ::: "memory")
#define PG8_BAR __builtin_amdgcn_s_barrier()
#define PG8_SCHED __builtin_amdgcn_sched_barrier(0)
    Unit cur, nxt; int ui = 0;
    if (!S.next(0, cur)) return;
    f32x4 acc[2][2][4][2];
#pragma unroll
    for (int a = 0; a < 2; ++a)
#pragma unroll
        for (int b = 0; b < 2; ++b)
#pragma unroll
            for (int m = 0; m < 4; ++m)
#pragma unroll
                for (int n = 0; n < 2; ++n) acc[a][b][m][n] = (f32x4){0.f, 0.f, 0.f, 0.f};
    bf16x8 At[4][2], B0[2][2], B1[2][2];
    const char* cA = (const char*)g.A + (size_t)cur.pm * tstep + (size_t)cur.ks * K * 2; const char* cB = (const char*)g.Bt + (size_t)cur.pn * tstep + (size_t)cur.ks * K * 2;
    S.a_ready(cur);
    if constexpr (SP2) {
        PG8_STAGE(PG8_SB(0, 0), cB, voffB); PG8_STAGE(PG8_SB(0, 1), cB + hstep, voffB); PG8_STAGE(PG8_SA(0, 0), cA, voffA); PG8_STAGE(PG8_SA(0, 1), cA + hstep, voffA);
        if (wr == 1) PG8_BAR;
        PG8_WAIT_V(2); PG8_BAR;
        PG8_STAGE(PG8_SB(1, 0), cB + kstep, voffB); PG8_STAGE(PG8_SA(1, 0), cA + kstep, voffA); PG8_STAGE(PG8_SB(1, 1), cB + hstep + kstep, voffB);
        PG8_WAIT_V(6); PG8_BAR;
    } else {
        PG8_STAGE(PG8_SB(0, 0), cB, voffB); PG8_STAGE(PG8_SA(0, 0), cA, voffA); PG8_STAGE(PG8_SB(0, 1), cB + hstep, voffB); PG8_STAGE(PG8_SA(0, 1), cA + hstep, voffA);
        if (wr == 1) PG8_BAR;
        PG8_WAIT_V(4); PG8_BAR;
        PG8_STAGE(PG8_SB(1, 0), cB + kstep, voffB); PG8_STAGE(PG8_SA(1, 0), cA + kstep, voffA); PG8_STAGE(PG8_SB(1, 1), cB + hstep + kstep, voffB);
        PG8_WAIT_V(6); PG8_BAR;
    }
    for (;;) {
        const bool has_next = S.next(ui + 1, nxt);
        const char* nA = has_next ? (const char*)g.A + (size_t)nxt.pm * tstep + (size_t)nxt.ks * K * 2 : cA; const char* nB = has_next ? (const char*)g.Bt + (size_t)nxt.pn * tstep + (size_t)nxt.ks * K * 2 : cB;
        for (int t = 0; t < nt; t += 2) {
            const bool last = (t == nt - 2);
            const char* a1 = cA + (size_t)(t + 1) * kstep;
            const char* a2 = last ? nA : cA + (size_t)(t + 2) * kstep; const char* b2 = last ? nB : cB + (size_t)(t + 2) * kstep;
            const char* a3 = a2 + kstep; const char* b3 = b2 + kstep;
            if (last && has_next) S.a_ready(nxt);
            if constexpr (SP2) {
            PG8_LDB(B0, 0, 0); PG8_LDB(B1, 0, 1); PG8_SCHED; PG8_LDA(At, 0, 0); PG8_STAGE(PG8_SA(1, 1), a1 + hstep, voffA);
            PG8_WAIT_V(8); PG8_WAIT_L(0); PG8_BAR; PG8_MMA(0, 0, At, B0); PG8_MMA(0, 1, At, B1); PG8_BAR; PG8_SCHED;
            PG8_LDA(At, 0, 1); PG8_STAGE(PG8_SB(0, 0), b2, voffB); PG8_STAGE(PG8_SB(0, 1), b2 + hstep, voffB); PG8_STAGE(PG8_SA(0, 0), a2, voffA);
            PG8_WAIT_V(8); PG8_WAIT_L(0); PG8_BAR; PG8_MMA(1, 0, At, B0); PG8_MMA(1, 1, At, B1); PG8_BAR; PG8_SCHED;
            PG8_LDB(B0, 1, 0); PG8_LDB(B1, 1, 1); PG8_SCHED; PG8_LDA(At, 1, 0); PG8_STAGE(PG8_SA(0, 1), a2 + hstep, voffA);
            PG8_WAIT_V(8); PG8_WAIT_L(0); PG8_BAR; PG8_MMA(0, 0, At, B0); PG8_MMA(0, 1, At, B1); PG8_BAR; PG8_SCHED;
            PG8_LDA(At, 1, 1); PG8_STAGE(PG8_SB(1, 0), b3, voffB); PG8_STAGE(PG8_SB(1, 1), b3 + hstep, voffB); PG8_STAGE(PG8_SA(1, 0), a3, voffA);
            PG8_WAIT_V(8); PG8_WAIT_L(0); PG8_BAR; PG8_MMA(1, 0, At, B0); PG8_MMA(1, 1, At, B1); PG8_BAR; PG8_SCHED;
            } else {
            PG8_LDB(B0, 0, 0); PG8_SCHED; PG8_LDA(At, 0, 0); PG8_STAGE(PG8_SA(1, 1), a1 + hstep, voffA);
            PG8_WAIT_L(8); PG8_BAR; PG8_WAIT_L(0); PG8_MMA(0, 0, At, B0); PG8_BAR; PG8_SCHED;
            PG8_LDB(B1, 0, 1); PG8_STAGE(PG8_SB(0, 0), b2, voffB);
            PG8_BAR; PG8_WAIT_L(0); PG8_MMA(0, 1, At, B1); PG8_BAR;
            PG8_LDA(At, 0, 1); PG8_STAGE(PG8_SA(0, 0), a2, voffA);
            PG8_BAR; PG8_WAIT_L(0); PG8_MMA(1, 0, At, B0); PG8_BAR; PG8_SCHED;
            PG8_STAGE(PG8_SB(0, 1), b2 + hstep, voffB);
            PG8_WAIT_V(6); PG8_BAR; PG8_MMA(1, 1, At, B1); PG8_BAR;
            PG8_LDB(B0, 1, 0); PG8_SCHED; PG8_LDA(At, 1, 0); PG8_STAGE(PG8_SA(0, 1), a2 + hstep, voffA);
            PG8_WAIT_L(8); PG8_BAR; PG8_WAIT_L(0); PG8_MMA(0, 0, At, B0); PG8_BAR; PG8_SCHED;
            PG8_LDB(B1, 1, 1); PG8_STAGE(PG8_SB(1, 0), b3, voffB);
            PG8_BAR; PG8_WAIT_L(0); PG8_MMA(0, 1, At, B1); PG8_BAR;
            PG8_LDA(At, 1, 1); PG8_STAGE(PG8_SA(1, 0), a3, voffA);
            PG8_BAR; PG8_WAIT_L(0); PG8_MMA(1, 0, At, B0); PG8_BAR; PG8_SCHED;
            PG8_STAGE(PG8_SB(1, 1), b3 + hstep, voffB);
            PG8_WAIT_V(6); PG8_BAR; PG8_MMA(1, 1, At, B1); PG8_BAR;
            }
        }
        if constexpr (ALIGN_EPI) { if (wr == 0) PG8_BAR; }
        if constexpr (!Epi::AFTER_DRAIN) { E(acc, cur, wr, wc, fr, fq); S.done(cur); }
        if (!has_next) break;
#pragma unroll
        for (int a = 0; a < 2; ++a)
#pragma unroll
            for (int b = 0; b < 2; ++b)
#pragma unroll
                for (int m = 0; m < 4; ++m)
#pragma unroll
                    for (int n = 0; n < 2; ++n) acc[a][b][m][n] = (f32x4){0.f, 0.f, 0.f, 0.f};
        cur = nxt; cA = nA; cB = nB; ++ui;
        if constexpr (ALIGN_EPI) { if (wr == 1) PG8_BAR; }
    }
    PG8_WAIT_V(0);
    if constexpr (!ALIGN_EPI) { if (wr == 0) PG8_BAR; }
    PG8_BAR;
    if constexpr (Epi::AFTER_DRAIN) { E.fused(acc, cur, wr, wc, fr, fq, lds, wid, lane); S.done(cur); }
#undef PG8_SA
#undef PG8_SB
#undef PG8_STAGE
#undef PG8_LDA
#undef PG8_LDB
#undef PG8_MMA
#undef PG8_WAIT_V
#undef PG8_WAIT_L
#undef PG8_BAR
#undef PG8_SCHED
}
}

constexpr int DM = 2048, NB = 4, SEQ = 2048, TP = 2064, NS = 128, TS = 4;
constexpr int MP = NB * TP;
constexpr int MR = MP + NS * TS;
constexpr int MPAD = 8960;
constexpr int RC = 3360;
constexpr int NIN = 7680;
constexpr int DFF = 5632;
constexpr int NTP = 2068;

constexpr size_t MiB = 1u << 20;
constexpr size_t ARR = (size_t)MR * 1024 * 4;
constexpr size_t WS_LT = 128 * 1024;
constexpr size_t WS_CS = 1 * MiB, WS_BON = 3 * MiB + 256 * 1024, WS_WOUT = 4 * MiB, WS_XN = 12 * MiB, WS_ZA = 47 * MiB, WS_ZB = 162 * MiB;
constexpr size_t WS_W = 232 * MiB, WS_RKAB = WS_W + ARR, WS_G = WS_RKAB + 2 * ARR, WS_O = WS_G + ARR, WS_ORET = WS_O + ARR;
constexpr size_t WS_R = WS_W;
constexpr size_t WS_WIN = 232 * MiB;
constexpr size_t WS_H = 47 * MiB, WS_WGU = WS_ORET + (size_t)MP * 1024 * 4, WS_WDN = WS_WGU + 44 * MiB, WS_ACT = 232 * MiB;
constexpr size_t WS_PART = WS_G;
constexpr size_t WS_END = WS_WDN + 22 * MiB;
static_assert(WS_END <= 512 * MiB, "ws map");
static_assert(WS_ZA + (size_t)MPAD * RC * 4 <= WS_ZB && WS_ZB + (size_t)MPAD * 4096 * 2 <= WS_R && WS_ACT + (size_t)MPAD * 5632 * 2 <= WS_G && WS_PART + 52 * MiB <= WS_WGU, "ws map 2");
static_assert(WS_CS + (size_t)NTP * 128 * 8 <= WS_BON && WS_BON + (size_t)MR * 16 * 4 <= WS_WOUT, "ws map 3");

constexpr size_t OUT_YP = 0, OUT_YS = 16777216, OUT_SHP = 17825792, OUT_RWP = 17839232, OUT_RTP = 18101376, OUT_SHS = 19149952, OUT_RWS = 19580032, OUT_RTS = 27968640;

constexpr int LDS_BYTES = 147456;
constexpr int NPH = 10;

#define LAS __attribute__((address_space(3)))
typedef unsigned short bf16;
typedef unsigned v4u __attribute__((ext_vector_type(4)));
typedef unsigned v2u __attribute__((ext_vector_type(2)));
typedef float f32x4 __attribute__((ext_vector_type(4)));
typedef float f32x2 __attribute__((ext_vector_type(2)));
typedef short bf16x8 __attribute__((ext_vector_type(8)));

__device__ __forceinline__ unsigned f2bf(float f) { unsigned u = __builtin_bit_cast(unsigned, f); return (u + 0x7fffu + ((u >> 16) & 1u)) >> 16; }
__device__ __forceinline__ unsigned pk2(float lo, float hi) { return f2bf(lo) | (f2bf(hi) << 16); }
__device__ __forceinline__ float bf2f(unsigned b) { return __builtin_bit_cast(float, b << 16); }
__device__ __forceinline__ float wave_sum(float v) {
#pragma unroll
    for (int o = 1; o < 64; o <<= 1) v += __shfl_xor(v, o);
    return v;
}
__device__ __forceinline__ float half_sum(float v) {
#pragma unroll
    for (int o = 1; o < 32; o <<= 1) v += __shfl_xor(v, o);
    return v;
}
#define DPP_ROR(x, n) __builtin_bit_cast(float, __builtin_amdgcn_update_dpp(0, __builtin_bit_cast(int, (x)), 0x120 + (n), 0xf, 0xf, false))
__device__ __forceinline__ float rowsum16(float x) {
    x += DPP_ROR(x, 8); x += DPP_ROR(x, 4); x += DPP_ROR(x, 2); x += DPP_ROR(x, 1);
    return x;
}

__device__ __forceinline__ float fma_s(float a, float b, float c) { float d; asm("v_fma_f32 %0, %1, %2, %3" : "=v"(d) : "v"(a), "v"(b), "v"(c)); return d; }
__device__ __forceinline__ float mul_s(float a, float b) { float d; asm("v_mul_f32 %0, %1, %2" : "=v"(d) : "v"(a), "v"(b)); return d; }
__device__ __forceinline__ float add_s(float a, float b) { float d; asm("v_add_f32 %0, %1, %2" : "=v"(d) : "v"(a), "v"(b)); return d; }
#define SCAN_STEP(S, r4, w4, k4, a4, b4, vi, ov) do { \
    const float sa_ = rowsum16(add_s(fma_s(S.y, a4.y, mul_s(S.x, a4.x)), fma_s(S.w, a4.w, mul_s(S.z, a4.z)))); \
    S.x = fma_s(S.x, w4.x, fma_s(sa_, b4.x, mul_s(vi, k4.x))); S.y = fma_s(S.y, w4.y, fma_s(sa_, b4.y, mul_s(vi, k4.y))); \
    S.z = fma_s(S.z, w4.z, fma_s(sa_, b4.z, mul_s(vi, k4.z))); S.w = fma_s(S.w, w4.w, fma_s(sa_, b4.w, mul_s(vi, k4.w))); \
    ov = rowsum16(add_s(fma_s(S.y, r4.y, mul_s(S.x, r4.x)), fma_s(S.w, r4.w, mul_s(S.z, r4.z)))); } while (0)

__device__ __forceinline__ float fexp(float x) { return __expf(x); }
__device__ __forceinline__ float frcp(float x) { return __builtin_amdgcn_rcpf(x); }
__device__ __forceinline__ float fsig(float x) { return frcp(1.0f + __expf(-x)); }
__device__ __forceinline__ float ftanh(float x) { return 1.0f - 2.0f * frcp(1.0f + __expf(2.0f * x)); }
__device__ __forceinline__ float sigmoid_f(float x) { return 1.0f / (1.0f + expf(-x)); }

struct Args { const float* in[25]; float* out; unsigned char* ws; int ph_lo, ph_hi, sub, pad; };

__device__ __forceinline__ void transpose_item(const float* W, int K, int N, bf16* WT, int mode, LAS float* scr, int item, int lane) {
    const int nblk = N / 32, kb = item / nblk, nb = item % nblk, k0 = 64 * kb, n0 = 32 * nb;
#pragma unroll
    for (int i = 0; i < 32; ++i) { const int kk = 2 * i + (lane >> 5); scr[kk * 33 + (lane & 31)] = __builtin_nontemporal_load(W + (size_t)(k0 + kk) * N + n0 + (lane & 31)); }
    asm volatile("s_waitcnt lgkmcnt(0)" ::: "memory");
    int r0 = n0;
    if (mode == 1) r0 = n0 < RC ? n0 : n0 + 224;
    else if (mode == 2) r0 = 256 * (n0 >> 7) + (n0 & 127);
    else if (mode == 3) r0 = 256 * (n0 >> 7) + (n0 & 127) + 128;
    const int c = lane & 7;
#pragma unroll
    for (int j = 0; j < 4; ++j) { const int n = (lane >> 3) + 8 * j; const LAS float* s = scr + (8 * c) * 33 + n;
        v4u o; o.x = pk2(s[0 * 33], s[1 * 33]); o.y = pk2(s[2 * 33], s[3 * 33]); o.z = pk2(s[4 * 33], s[5 * 33]); o.w = pk2(s[6 * 33], s[7 * 33]);
        *(v4u*)(WT + (size_t)(r0 + n) * K + k0 + 8 * c) = o; }
    asm volatile("s_waitcnt lgkmcnt(0)" ::: "memory");
}
__device__ __forceinline__ void rms_row_bf16(const float* xrow, const float* gain, bf16* orow, int lane) {
    f32x4 v[8]; float s = 0.f;
#pragma unroll
    for (int j = 0; j < 8; ++j) { v[j] = *(const f32x4*)(xrow + 4 * lane + 256 * j); s += (v[j].x * v[j].x + v[j].y * v[j].y) + (v[j].z * v[j].z + v[j].w * v[j].w); }
    const float rs = 1.0f / sqrtf(wave_sum(s) * (1.0f / 2048.0f) + 1e-6f);
#pragma unroll
    for (int j = 0; j < 8; ++j) { const f32x4 g = *(const f32x4*)(gain + 4 * lane + 256 * j);
        v2u o; o.x = pk2(v[j].x * rs * g.x, v[j].y * rs * g.y); o.y = pk2(v[j].z * rs * g.z, v[j].w * rs * g.w);
        *(v2u*)(orow + 4 * lane + 256 * j) = o; }
}
template <bool NT = false>
__device__ __forceinline__ void rms_rows2_bf16(const float* x0, const float* x1, const float* gain, bf16* o0, bf16* o1, int lane) {
    f32x4 v[8], u[8]; float s = 0.f, t = 0.f;
#pragma unroll
    for (int j = 0; j < 8; ++j) { if (NT) { v[j] = __builtin_nontemporal_load((const f32x4*)(x0 + 4 * lane + 256 * j)); u[j] = __builtin_nontemporal_load((const f32x4*)(x1 + 4 * lane + 256 * j)); }
        else { v[j] = *(const f32x4*)(x0 + 4 * lane + 256 * j); u[j] = *(const f32x4*)(x1 + 4 * lane + 256 * j); } }
#pragma unroll
    for (int j = 0; j < 8; ++j) { s += (v[j].x * v[j].x + v[j].y * v[j].y) + (v[j].z * v[j].z + v[j].w * v[j].w); t += (u[j].x * u[j].x + u[j].y * u[j].y) + (u[j].z * u[j].z + u[j].w * u[j].w); }
    const float rs = 1.0f / sqrtf(wave_sum(s) * (1.0f / 2048.0f) + 1e-6f), rt = 1.0f / sqrtf(wave_sum(t) * (1.0f / 2048.0f) + 1e-6f);
#pragma unroll
    for (int j = 0; j < 8; ++j) { const f32x4 g = *(const f32x4*)(gain + 4 * lane + 256 * j);
        v2u a; a.x = pk2(v[j].x * rs * g.x, v[j].y * rs * g.y); a.y = pk2(v[j].z * rs * g.z, v[j].w * rs * g.w); *(v2u*)(o0 + 4 * lane + 256 * j) = a;
        v2u b; b.x = pk2(u[j].x * rt * g.x, u[j].y * rt * g.y); b.y = pk2(u[j].z * rt * g.z, u[j].w * rt * g.w); *(v2u*)(o1 + 4 * lane + 256 * j) = b; }
}
__device__ __forceinline__ void zero_row_bf16(bf16* orow, int lane) {
#pragma unroll
    for (int j = 0; j < 8; ++j) *(v2u*)(orow + 4 * lane + 256 * j) = (v2u){0u, 0u};
}
__device__ __forceinline__ float zprev_val(const float* ZA, const float* sshift, int row, int col) {
    if (row < MP) { const int p = row % TP; return p == 0 ? 0.f : ZA[(size_t)(row - 1) * RC + col]; }
    const int r = row - MP; return (r & 3) == 0 ? sshift[(size_t)(r >> 2) * RC + col] : ZA[(size_t)(row - 1) * RC + col];
}

template <int MT, int NT, int KS>
__device__ __forceinline__ void wave_mma(f32x4 (&acc)[MT][NT], const LAS unsigned char* A, int lda, const LAS unsigned char* B, int ldb, int fr, int fq) {
#pragma unroll 2
    for (int ks = 0; ks < KS; ++ks) {
        bf16x8 a[MT], b[NT];
#pragma unroll
        for (int mi = 0; mi < MT; ++mi) a[mi] = *(const LAS bf16x8*)(A + (mi * 16 + fr) * lda + (ks * 32 + fq * 8) * 2);
#pragma unroll
        for (int ni = 0; ni < NT; ++ni) b[ni] = *(const LAS bf16x8*)(B + (ni * 16 + fr) * ldb + (ks * 32 + fq * 8) * 2);
#pragma unroll
        for (int mi = 0; mi < MT; ++mi)
#pragma unroll
            for (int ni = 0; ni < NT; ++ni) acc[mi][ni] = __builtin_amdgcn_mfma_f32_16x16x32_bf16(a[mi], b[ni], acc[mi][ni], 0, 0, 0);
    }
}

__device__ __forceinline__ float ret_lg2(int h) { return h == 0 ? -0.04580368961312479f : (h == 1 ? -0.02272007650008353f : (h == 2 ? -0.011315313227834146f : -0.005646563141142063f)); }

__device__ __forceinline__ void ret_prompt_unit(LAS unsigned char* L, const bf16* ZB, float* ORET, float* retp, int unit, int tid) {
    const int lane = tid & 63, wave = tid >> 6, fr = lane & 15, fq = lane >> 4;
    const int b = unit >> 5, h = (unit >> 3) & 3, es = unit & 7;
    const float lg2 = ret_lg2(h);
    LAS unsigned char* Q = L; LAS unsigned char* R2 = L + 67584; LAS unsigned char* VT = L + 137216;
    LAS unsigned char* P = R2; LAS unsigned char* ST = R2 + 34816; LAS unsigned char* KT = R2;
    f32x4 S[2][2];
#pragma unroll
    for (int a = 0; a < 2; ++a)
#pragma unroll
        for (int c = 0; c < 2; ++c) S[a][c] = (f32x4){0.f, 0.f, 0.f, 0.f};
    v4u qn[8], kn[8], vn;
    const int vj = tid & 127, veg = tid >> 7;
#define RET_LOAD(ch_) do { const int C_ = (ch_) == 0 ? 16 : 128, rb_ = b * TP + ((ch_) == 0 ? 0 : 16 + ((ch_) - 1) * 128); \
        const bf16* src_ = ZB + (size_t)(rb_ + vj) * 4096 + h * 256 + veg * 8; \
        _Pragma("unroll") for (int it = 0; it < 8; ++it) { qn[it] = (v4u){0u, 0u, 0u, 0u}; kn[it] = qn[it]; \
            if (vj < C_) { qn[it] = *(const v4u*)(src_ + it * 32); kn[it] = *(const v4u*)(src_ + 1024 + it * 32); } } \
        vn = (v4u){0u, 0u, 0u, 0u}; if (vj < C_) vn = *(const v4u*)(src_ + 2048 + es * 32); } while (0)
    RET_LOAD(0);
    for (int ch = 0; ch < 17; ++ch) {
        const int C = ch == 0 ? 16 : 128, tok0 = ch == 0 ? 0 : 16 + (ch - 1) * 128, rowbase = b * TP + tok0;
#pragma unroll
        for (int it = 0; it < 8; ++it) {
            *(LAS v4u*)(Q + vj * 528 + veg * 16 + it * 64) = qn[it];
            *(LAS v4u*)(R2 + vj * 528 + veg * 16 + it * 64) = kn[it]; }
#pragma unroll
        for (int x = 0; x < 4; ++x) { const unsigned w = vn[x];
            *(LAS unsigned short*)(VT + (veg * 8 + 2 * x) * 272 + vj * 2) = (unsigned short)(w & 0xffffu);
            *(LAS unsigned short*)(VT + (veg * 8 + 2 * x + 1) * 272 + vj * 2) = (unsigned short)(w >> 16); }
        __syncthreads();
        f32x4 sc[4][2];
#pragma unroll
        for (int a = 0; a < 4; ++a)
#pragma unroll
            for (int c = 0; c < 2; ++c) sc[a][c] = (f32x4){0.f, 0.f, 0.f, 0.f};
        const int mt0 = (wave >> 1) * 2, nt0 = (wave & 1) * 4;
        wave_mma<4, 2, 8>(sc, R2 + nt0 * 16 * 528, 528, Q + mt0 * 16 * 528, 528, fr, fq);
        __syncthreads();
        float lg2v = lg2; asm volatile("" : "+v"(lg2v));
        const float gi1 = exp2f(-lg2v), gi2 = gi1 * gi1, gi3 = gi2 * gi1;
#pragma unroll
        for (int mi = 0; mi < 4; ++mi)
#pragma unroll
            for (int ni = 0; ni < 2; ++ni) { const int j0 = (nt0 + mi) * 16 + 4 * fq, i = (mt0 + ni) * 16 + fr;
                const float e0 = exp2f(lg2v * (float)(i - j0));
                float pv[4];
                pv[0] = i >= j0 ? sc[mi][ni][0] * e0 : 0.f; pv[1] = i >= j0 + 1 ? sc[mi][ni][1] * (e0 * gi1) : 0.f;
                pv[2] = i >= j0 + 2 ? sc[mi][ni][2] * (e0 * gi2) : 0.f; pv[3] = i >= j0 + 3 ? sc[mi][ni][3] * (e0 * gi3) : 0.f;
                v2u w; w.x = pk2(pv[0], pv[1]); w.y = pk2(pv[2], pv[3]);
                *(LAS v2u*)(P + i * 272 + j0 * 2) = w; }
#pragma unroll
        for (int dt = 0; dt < 2; ++dt)
#pragma unroll
            for (int et = 0; et < 2; ++et) { const int d = (2 * wave + dt) * 16 + 4 * fq, e = et * 16 + fr;
                v2u w; w.x = pk2(S[dt][et][0], S[dt][et][1]); w.y = pk2(S[dt][et][2], S[dt][et][3]);
                *(LAS v2u*)(ST + e * 528 + d * 2) = w; }
        __syncthreads();
        f32x4 o1[1][2], o2[1][2];
        o1[0][0] = o1[0][1] = o2[0][0] = o2[0][1] = (f32x4){0.f, 0.f, 0.f, 0.f};
        wave_mma<1, 2, 4>(o1, P + wave * 16 * 272, 272, VT, 272, fr, fq);
        wave_mma<1, 2, 8>(o2, Q + wave * 16 * 528, 528, ST, 528, fr, fq);
#pragma unroll
        for (int ni = 0; ni < 2; ++ni)
#pragma unroll
            for (int r = 0; r < 4; ++r) { const int i = wave * 16 + 4 * fq + r, e = ni * 16 + fr;
                if (i < C) ORET[(size_t)(rowbase + i) * 1024 + h * 256 + es * 32 + e] = o1[0][ni][r] + exp2f(lg2v * (float)(i + 1)) * o2[0][ni][r]; }
        __syncthreads();
        const float sdec = vj < C ? exp2f(lg2v * (float)(C - 1 - vj)) : 0.f;
#pragma unroll
        for (int it = 0; it < 8; ++it) { const int j = vj, db = veg + 4 * it;
#pragma unroll
            for (int x = 0; x < 4; ++x) { const unsigned w = kn[it][x];
                *(LAS unsigned short*)(KT + (db * 8 + 2 * x) * 272 + j * 2) = (unsigned short)f2bf(bf2f(w & 0xffffu) * sdec);
                *(LAS unsigned short*)(KT + (db * 8 + 2 * x + 1) * 272 + j * 2) = (unsigned short)f2bf(bf2f(w >> 16) * sdec); } }
        if (ch + 1 < 17) RET_LOAD(ch + 1);
        __syncthreads();
        const float gC = exp2f(lg2 * (float)C);
#pragma unroll
        for (int a = 0; a < 2; ++a)
#pragma unroll
            for (int c = 0; c < 2; ++c) S[a][c] *= gC;
        wave_mma<2, 2, 4>(S, KT + (2 * wave) * 16 * 272, 272, VT, 272, fr, fq);
        __syncthreads();
    }
#undef RET_LOAD
#pragma unroll
    for (int dt = 0; dt < 2; ++dt)
#pragma unroll
        for (int et = 0; et < 2; ++et)
#pragma unroll
            for (int r = 0; r < 4; ++r) { const int d = (2 * wave + dt) * 16 + 4 * fq + r, e = es * 32 + et * 16 + fr;
                retp[((size_t)(b * 4 + h) * 256 + d) * 256 + e] = S[dt][et][r]; }
}

__device__ __forceinline__ void ret_sample_unit(LAS unsigned char* L, const bf16* ZB, const float* sret, float* rets, bf16* OAB, int unit, int tid) {
    const int lane = tid & 63, wave = tid >> 6;
    const int s = unit >> 2, h = unit & 3;
    const float lg2 = ret_lg2(h);
    LAS float* qs = (LAS float*)L;
    LAS float* ks = qs + 1024;
    LAS float* qr = ks + 1024;
    LAS float* kr = qr + 1024;
    LAS float* scs = kr + 1024;
    LAS float* part = scs + 16;
    LAS float* red = part + 2048;
    const int rowb = MP + 4 * s;
    for (int idx = tid; idx < 1024; idx += 512) { const int i = idx >> 8, d = idx & 255;
        const bf16* src = ZB + (size_t)(rowb + i) * 4096 + h * 256 + d;
        const float q = bf2f(src[0]), k = bf2f(src[1024]);
        qr[idx] = q; kr[idx] = k; qs[d * 4 + i] = q * exp2f(lg2 * (float)(i + 1)); ks[d * 4 + i] = k * exp2f(lg2 * (float)(3 - i)); }
    __syncthreads();
#pragma unroll
    for (int pp = 0; pp < 2; ++pp) { const int pr = 2 * wave + pp, i = pr >> 2, j = pr & 3;
        const f32x4 a = *(const LAS f32x4*)(qr + i * 256 + 4 * lane), c = *(const LAS f32x4*)(kr + j * 256 + 4 * lane);
        float d = (a.x * c.x + a.y * c.y) + (a.z * c.z + a.w * c.w); d = wave_sum(d);
        if (lane == 0) scs[pr] = i >= j ? d * exp2f(lg2 * (float)(i - j)) : 0.f; }
    const int e = tid & 255, hf = tid >> 8;
    float v[4];
#pragma unroll
    for (int j = 0; j < 4; ++j) v[j] = bf2f(ZB[(size_t)(rowb + j) * 4096 + 2048 + h * 256 + e]);
    const float g4 = exp2f(lg2 * 4.0f);
    const float* S0 = sret + ((size_t)(s * 4 + h) * 256 + hf * 128) * 256 + e;
    float* S1 = rets + ((size_t)(s * 4 + h) * 256 + hf * 128) * 256 + e;
    float o[4] = {0.f, 0.f, 0.f, 0.f};
    for (int dd = 0; dd < 128; dd += 8) {
        float sv[8];
#pragma unroll
        for (int u = 0; u < 8; ++u) sv[u] = S0[(size_t)(dd + u) * 256];
#pragma unroll
        for (int u = 0; u < 8; ++u) { const int d = hf * 128 + dd + u;
            const f32x4 q4 = *(const LAS f32x4*)(qs + d * 4), k4 = *(const LAS f32x4*)(ks + d * 4);
            o[0] += q4.x * sv[u]; o[1] += q4.y * sv[u]; o[2] += q4.z * sv[u]; o[3] += q4.w * sv[u];
            S1[(size_t)(dd + u) * 256] = g4 * sv[u] + ((k4.x * v[0] + k4.y * v[1]) + (k4.z * v[2] + k4.w * v[3])); }
    }
#pragma unroll
    for (int i = 0; i < 4; ++i) part[(hf * 4 + i) * 256 + e] = o[i];
    __syncthreads();
    float oo[2], ss[2];
#pragma unroll
    for (int ii = 0; ii < 2; ++ii) { const int i = hf * 2 + ii;
        float x = part[i * 256 + e] + part[(4 + i) * 256 + e];
#pragma unroll
        for (int j = 0; j < 4; ++j) x += scs[i * 4 + j] * v[j];
        oo[ii] = x; ss[ii] = wave_sum(x * x); }
    if (lane == 0) { red[wave * 2] = ss[0]; red[wave * 2 + 1] = ss[1]; }
    __syncthreads();
#pragma unroll
    for (int ii = 0; ii < 2; ++ii) { const int i = hf * 2 + ii; const int w0 = hf * 4;
        const float tot = (red[w0 * 2 + ii] + red[(w0 + 1) * 2 + ii]) + (red[(w0 + 2) * 2 + ii] + red[(w0 + 3) * 2 + ii]);
        const float rs = 1.0f / sqrtf(tot * (1.0f / 256.0f) + 1e-6f);
        const float g = bf2f(ZB[(size_t)(rowb + i) * 4096 + 3072 + h * 256 + e]);
        OAB[(size_t)(rowb + i) * 2048 + 1024 + h * 256 + e] = (bf16)f2bf(oo[ii] * rs * (g / (1.0f + expf(-g)))); }
    __syncthreads();
}


#define IN_(k) (args.in[k])
#define x_prompt IN_(0)
#define x_sample IN_(1)
#define state_shift IN_(2)
#define state_rwkv IN_(3)
#define state_ret IN_(4)
#define meta IN_(5)
#define norm_mix IN_(6)
#define w_in IN_(7)
#define mu IN_(8)
#define w0 IN_(9)
#define w2 IN_(10)
#define a0 IN_(11)
#define a2 IN_(12)
#define g2 IN_(13)
#define k_k IN_(14)
#define k_a IN_(15)
#define r_k IN_(16)
#define ln_w IN_(17)
#define ln_b IN_(18)
#define w_out IN_(19)
#define norm_ffn IN_(20)
#define w_gate IN_(21)
#define w_up IN_(22)
#define w_down IN_(23)
#define norm_final IN_(24)
#define out (args.out)
#define CS ((float*)(ws + WS_CS))
#define BON ((float*)(ws + WS_BON))
#define WT_IN ((bf16*)(ws + WS_WIN))
#define WT_OUT ((bf16*)(ws + WS_WOUT))
#define WT_GU ((bf16*)(ws + WS_WGU))
#define WT_DN ((bf16*)(ws + WS_WDN))
#define XN ((bf16*)(ws + WS_XN))
#define OAB ((bf16*)(ws + WS_XN))
#define ZA ((float*)(ws + WS_ZA))
#define ZB ((bf16*)(ws + WS_ZB))
#define RKAB ((bf16*)(ws + WS_RKAB))
#define aW ((float*)(ws + WS_W))
#define aG ((float*)(ws + WS_G))
#define aO ((float*)(ws + WS_O))
#define ORET ((float*)(ws + WS_ORET))
#define H ((float*)(ws + WS_H))
#define ACT ((bf16*)(ws + WS_ACT))

typedef __attribute__((address_space(1))) unsigned gu32;
#define RLX_AGENT __ATOMIC_RELAXED, __HIP_MEMORY_SCOPE_AGENT
#define XB_TMO      128
#define XB_XCNT(j)  (256  + 64 * (j))
#define XB_XSUB(j)  (1280 + 64 * (j))
#define XB_XGEN(j)  (2304 + 64 * (j))
#define XB_TOP      3328
#define XB_TOPGEN   3392
#define XCD_BAR_WORDS 3456
#define XB_SPIN_CAP (1u << 18)

__device__ __forceinline__ unsigned xb_ld(unsigned* p)              { return __hip_atomic_load(p, __ATOMIC_RELAXED, __HIP_MEMORY_SCOPE_AGENT); }
__device__ __forceinline__ unsigned xb_add(unsigned* p, unsigned v) { return __hip_atomic_fetch_add(p, v, __ATOMIC_RELAXED, __HIP_MEMORY_SCOPE_AGENT); }
__device__ __forceinline__ unsigned xb_xcc_id() { return (unsigned)__builtin_amdgcn_s_getreg((3 << 11) | 20) & 0xFu; }
#define XB_SPIN(cond, bar) do { unsigned _sp = 0; while (cond) { __builtin_amdgcn_s_sleep(1); \
    if ((++_sp & 255u) == 0u) { if (xb_ld(&(bar)[XB_TMO])) break; if (_sp > XB_SPIN_CAP) { atomicAdd(&(bar)[XB_TMO], 1u); break; } } } } while (0)

struct XcdBarrier {
    unsigned* bar; unsigned x;
    volatile LAS unsigned* st;
};

__device__ __forceinline__ XcdBarrier xcd_barrier_post(unsigned* bar, volatile LAS unsigned* st) {
    XcdBarrier b; b.bar = bar; b.x = xb_xcc_id(); b.st = st;
    if (threadIdx.x == 0) (void)xb_add(&bar[XB_XCNT(b.x)], 1u);
    return b;
}
__device__ __forceinline__ void xcd_barrier_complete(unsigned* bar, unsigned x, unsigned& nloc, unsigned& nx) {
    const unsigned G = gridDim.x * gridDim.y * gridDim.z;
    unsigned sum, cnt, mine, sp = 0u;
    for (;;) {
        sum = 0u; cnt = 0u; mine = 0u;
#pragma unroll
        for (unsigned j = 0; j < 16; ++j) { const unsigned c = xb_ld(&bar[XB_XCNT(j)]); sum += c; cnt += (c > 0u) ? 1u : 0u; mine = (j == x) ? c : mine; }
        if (sum == G) break;
        __builtin_amdgcn_s_sleep(1);
        if ((++sp & 255u) == 0u) { if (xb_ld(&bar[XB_TMO])) break; if (sp > XB_SPIN_CAP) { atomicAdd(&bar[XB_TMO], 1u); break; } }
    }
    nloc = mine > 0u ? mine : 1u; nx = cnt > 0u ? cnt : 1u;
}

__device__ __forceinline__ void xcd_barrier(const XcdBarrier& b) {
    asm volatile("s_waitcnt vmcnt(0)" ::: "memory");
    __syncthreads();
    if (threadIdx.x == 0) {
        unsigned* bar = b.bar;
        __builtin_amdgcn_s_waitcnt(0);
        unsigned nloc = b.st[0], nx = b.st[1];
        if (nloc == 0u) { xcd_barrier_complete(bar, b.x, nloc, nx); b.st[0] = nloc; b.st[1] = nx; }
        const unsigned old = xb_add(&bar[XB_XSUB(b.x)], 1u);
        const unsigned gen = old / nloc;
        if (old + 1u == (gen + 1u) * nloc) {
            __builtin_amdgcn_fence(__ATOMIC_RELEASE, "agent");
            asm volatile("s_waitcnt vmcnt(0)" ::: "memory");
            const unsigned og = xb_add(&bar[XB_TOP], 1u);
            const unsigned tg = og / nx;
            if (og + 1u == (tg + 1u) * nx) xb_add(&bar[XB_TOPGEN], 1u);
            else XB_SPIN(xb_ld(&bar[XB_TOPGEN]) == tg, bar);
            __builtin_amdgcn_fence(__ATOMIC_ACQUIRE, "agent");
            xb_add(&bar[XB_XGEN(b.x)], 1u);
            asm volatile("s_waitcnt vmcnt(0)" ::: "memory");
        } else {
            XB_SPIN(xb_ld(&bar[XB_XGEN(b.x)]) == gen, bar);
            __builtin_amdgcn_fence(__ATOMIC_ACQUIRE, "agent");
            asm volatile("s_waitcnt vmcnt(0)" ::: "memory");
        }
    }
    __syncthreads();
}

constexpr int MISC_OFF = 147328;


__device__ __forceinline__ void rkab_unpack(const v4u& X, const v4u& Y, f32x4& r4, f32x4& k4, f32x4& a4, f32x4& b4) {
    r4 = (f32x4){bf2f(X.x & 0xffffu), bf2f(X.z & 0xffffu), bf2f(Y.x & 0xffffu), bf2f(Y.z & 0xffffu)};
    k4 = (f32x4){bf2f(X.x >> 16), bf2f(X.z >> 16), bf2f(Y.x >> 16), bf2f(Y.z >> 16)};
    a4 = (f32x4){bf2f(X.y & 0xffffu), bf2f(X.w & 0xffffu), bf2f(Y.y & 0xffffu), bf2f(Y.w & 0xffffu)};
    b4 = (f32x4){bf2f(X.y >> 16), bf2f(X.w >> 16), bf2f(Y.y >> 16), bf2f(Y.w >> 16)};
}
__device__ __forceinline__ void sample_scan_units(const unsigned char* ws, const float* p_rwkv, const float* p_shift, const float* p_mu, float* outp, int wu0, int wu1, int stride, int lane) {
    const int ri = lane >> 4, cq = lane & 15;
    for (int wub = wu0; wub < wu1; wub += 2 * stride) {
        f32x4 S[2]; float vmu[2], zprev[2]; int vcol[2], hh[2], ss[2], irow[2]; bool ok[2];
#pragma unroll
        for (int q = 0; q < 2; ++q) { const int wu = wub + q * stride; ok[q] = wu < wu1; const int wuc = ok[q] ? wu : wub;
            ss[q] = wuc >> 8; hh[q] = (wuc >> 4) & 15; irow[q] = (wuc & 15) * 4 + ri;
            S[q] = *(const f32x4*)(p_rwkv + ((size_t)((ss[q] * 16 + hh[q]) * 64 + irow[q])) * 64 + cq * 4);
            vcol[q] = 2048 + hh[q] * 64 + irow[q]; vmu[q] = p_mu[vcol[q]]; zprev[q] = p_shift[(size_t)ss[q] * RC + vcol[q]]; }
#pragma unroll
        for (int t = 0; t < 4; ++t) {
            f32x4 r4[2], w4[2], k4[2], a4[2], b4[2]; float z[2];
#pragma unroll
            for (int q = 0; q < 2; ++q) { const int row = MP + 4 * ss[q] + t; const size_t o = (size_t)row * 1024 + hh[q] * 64 + cq * 4;
                w4[q] = *(const f32x4*)(aW + o); { const v4u X_ = *(const v4u*)(RKAB + o * 4), Y_ = *(const v4u*)(RKAB + o * 4 + 8); rkab_unpack(X_, Y_, r4[q], k4[q], a4[q], b4[q]); }
                z[q] = ZA[(size_t)row * RC + vcol[q]]; }
#pragma unroll
            for (int q = 0; q < 2; ++q) { const int row = MP + 4 * ss[q] + t; const float vi = z[q] + vmu[q] * (zprev[q] - z[q]); zprev[q] = z[q];
                float ov; SCAN_STEP(S[q], r4[q], w4[q], k4[q], a4[q], b4[q], vi, ov);
                if (cq == 0 && ok[q]) aO[(size_t)row * 1024 + hh[q] * 64 + irow[q]] = ov; } }
#pragma unroll
        for (int q = 0; q < 2; ++q) if (ok[q]) *(f32x4*)(outp + OUT_RWS + ((size_t)((ss[q] * 16 + hh[q]) * 64 + irow[q])) * 64 + cq * 4) = S[q];
    }
}
constexpr int SS_SPLIT = 12288;


template <class Epi, int NSL>
__device__ __forceinline__ void gemm_fixup(const Epi& E, const pg8::Unit& u, const pg8::f32x4* p, int am, int wave, int lane) {
    const int ai = am >> 2, m = am & 3;
    pg8::f32x4 a[2][2];
#pragma unroll
    for (int bj = 0; bj < 2; ++bj)
#pragma unroll
        for (int n = 0; n < 2; ++n) { const int r = ((ai * 2 + bj) * 4 + m) * 2 + n; pg8::f32x4 v = p[(size_t)r * 512];
#pragma unroll
            for (int s = 1; s < NSL; ++s) v += p[((size_t)s * 32 + r) * 512];
            a[bj][n] = v; }
    E.row(a, ai, m, u, wave >> 2, wave & 3, lane & 15, lane >> 4);
}
#define GEMM_SPLIT(EPI_T, g_, Nn, E_, NSL_, KS_) do { \
    pg8::StaticOrder S_; S_.init(MPAD, (Nn), G, (int)blockIdx.x); const int nfull_ = (S_.nwg / G) * G, ntail_ = S_.nwg - nfull_; S_.limit = nfull_; \
    pg8::gemm_phase<EPI_T, pg8::StaticOrder, true, true>(L, g_, S_, E_); \
    if (ntail_ > 0) { \
        pg8::SplitOrder SS_{S_, nfull_, ntail_, (NSL_)}; pg8::Gemm gs_ = g_; gs_.K = (KS_); pg8::EpiPartial EP_{(float*)(ws + WS_PART)}; \
        pg8::gemm_phase<pg8::EpiPartial, pg8::SplitOrder, true, true>(L, gs_, SS_, EP_); \
        xcd_barrier(bar); \
        for (int it_ = blockIdx.x; it_ < ntail_ * 8; it_ += G) { const int j_ = it_ >> 3; pg8::Unit u_; S_.map(nfull_ + j_, u_); gemm_fixup<EPI_T, (NSL_)>(E_, u_, (const pg8::f32x4*)(ws + WS_PART) + (size_t)j_ * (NSL_) * 32 * 512 + tid, it_ & 7, wave, lane); } } } while (0)
__global__ void __launch_bounds__(512, 2) fwd(Args args) {
    extern __shared__ __attribute__((aligned(16))) unsigned char lds_raw[];
    LAS unsigned char* L = (LAS unsigned char*)lds_raw;
    const int tid = threadIdx.x, lane = tid & 63, wave = __builtin_amdgcn_readfirstlane(tid >> 6);
    const int G = gridDim.x;
#define gw ((int)blockIdx.x * 8 + wave)
#define NGW (G * 8)
#define gt ((int)blockIdx.x * 512 + tid)
#define NGT (G * 512)
    unsigned char* ws = args.ws;
    const int lo = args.ph_lo, hi = args.ph_hi;
    if (tid < 32) ((LAS unsigned*)(L + MISC_OFF))[tid] = 0u;
    __syncthreads();
    XcdBarrier bar = xcd_barrier_post((unsigned*)ws + 1024, (volatile LAS unsigned*)(L + MISC_OFF) + 8);
    if (hi > 1000) cg::this_grid().sync();
#ifndef PHMASK
#define PHMASK 0x3ff
#endif
#define IN(k) (((PHMASK >> (k)) & 1) && lo <= (k) && (k) < hi)
#define SEAM(k) do { if (IN(k) && IN((k) + 1)) { xcd_barrier(bar); } } while (0)

    if (IN(0)) {
        LAS float* scr = (LAS float*)(L + wave * 16384);
        constexpr int I_IN = 32 * 233, I_OUT = 32 * 64;
        for (int it = gw; it < I_IN + I_OUT; it += NGW) {
            if (it < I_IN) transpose_item(w_in, 2048, 7456, WT_IN, 1, scr, it, lane);
            else transpose_item(w_out, 2048, 2048, WT_OUT, 0, scr, it - I_IN, lane);
        }
        for (int i = gt; i < 224 * 256; i += NGT) *(v4u*)(WT_IN + (size_t)RC * 2048 + (size_t)i * 8) = (v4u){0u, 0u, 0u, 0u};
        for (int idx = gt; idx < 1024 * 288; idx += NGT) { const int c = idx / 288, i = idx - c * 288;
            const float v = i < 64 ? w2[(size_t)i * 1024 + c] : (i < 128 ? a2[(size_t)(i - 64) * 1024 + c] : g2[(size_t)(i - 128) * 1024 + c]);
            ((bf16*)(ws + WS_LT))[idx] = (bf16)f2bf(v); }
        for (int idx = gt; idx < NTP * 128; idx += NGT) {
            const int tp = idx >> 7, i = idx & 127;
            const double pos = tp < TP ? (double)tp : (double)(16384 + tp - TP);
            double invf = 1.0; for (int k = 0; k < i; ++k) invf *= 0.9300449458481391;
            const double ang = pos * invf;
            const double n = __builtin_rint(ang * 0.15915494309189535);
            double r = __builtin_fma(-n, 6.283185307179586, ang); r = __builtin_fma(-n, 2.4492935982947064e-16, r);
            const double r2 = r * r; double sn = r, cn = 1.0, ts = r, tc = 1.0;
            for (int k = 1; k <= 15; ++k) { tc *= -r2 / (double)((2 * k - 1) * (2 * k)); ts *= -r2 / (double)((2 * k) * (2 * k + 1)); cn += tc; sn += ts; }
            CS[(size_t)idx * 2] = (float)cn; CS[(size_t)idx * 2 + 1] = (float)sn;
        }
        for (int m = gw; m < MPAD; m += 2 * NGW) { const int m1 = m + NGW;
            if (m1 < MR) rms_rows2_bf16<true>(pg8::xsrc_row(x_prompt, x_sample, meta, m), pg8::xsrc_row(x_prompt, x_sample, meta, m1), norm_mix, XN + (size_t)m * DM, XN + (size_t)m1 * DM, lane);
            else { if (m < MR) rms_row_bf16(pg8::xsrc_row(x_prompt, x_sample, meta, m), norm_mix, XN + (size_t)m * DM, lane); else zero_row_bf16(XN + (size_t)m * DM, lane);
                   if (m1 < MPAD) zero_row_bf16(XN + (size_t)m1 * DM, lane); }
        }
    }
    SEAM(0);
    if (IN(1)) {
        pg8::Gemm g{XN, WT_IN, MPAD, NIN, DM, DM};
        pg8::EpiIn E{ZA, ZB, CS};
        GEMM_SPLIT(pg8::EpiIn, g, NIN, E, 8, 256);
    }
    SEAM(1);
    if (IN(2)) {
        LAS unsigned char* X = L;
        const bf16* LT = (const bf16*)(ws + WS_LT);
        const int fr = lane & 15, fq = lane >> 4;
        if (args.sub & 1)
        for (int grp = blockIdx.x; grp < MR / 16; grp += G) {
            const int row0 = grp * 16;
            { float zv[9], zpv[9], muv[9]; int tidv = tid; asm volatile("" : "+v"(tidv));
#pragma unroll
            for (int it = 0; it < 9; ++it) { const int idx = tidv + 512 * it, t = idx / 288, i = idx - t * 288, row = row0 + t, col = 3072 + i;
                zv[it] = ZA[(size_t)row * RC + col]; zpv[it] = zprev_val(ZA, state_shift, row, col); muv[it] = mu[col]; }
#pragma unroll
            for (int it = 0; it < 9; ++it) { const int idx = tidv + 512 * it, t = idx / 288, i = idx - t * 288;
                const float zs = zv[it] + muv[it] * (zpv[it] - zv[it]);
                const float val = i < 64 ? ftanh(zs) : (i < 128 ? zs : fsig(zs));
                *(LAS unsigned short*)(X + t * 592 + i * 2) = (unsigned short)f2bf(val); } }
            __syncthreads();
            const int row = row0 + fr;
            const float* zrow = ZA + (size_t)row * RC; const float* pz;
            if (row < MP) pz = (row % TP) == 0 ? nullptr : zrow - RC;
            else { const int rr = row - MP; pz = (rr & 3) == 0 ? state_shift + (size_t)(rr >> 2) * RC : zrow - RC; }
#pragma unroll 1
            for (int hd = (args.sub & 64) ? 2 : 0; hd < 2; ++hd) { const int head = 2 * wave + hd;
                bf16x8 xf[9];
#pragma unroll
                for (int ks = 0; ks < 9; ++ks) xf[ks] = *(const LAS bf16x8*)(X + fr * 592 + (ks * 32 + 8 * fq) * 2);
                f32x4 aw[4], aa[4], ag[4];
#pragma unroll
                for (int t = 0; t < 4; ++t) { const bf16* wt = LT + (size_t)(head * 64 + 16 * t + fr) * 288 + 8 * fq;
                    aw[t] = (f32x4){0.f, 0.f, 0.f, 0.f}; aa[t] = aw[t]; ag[t] = aw[t];
#pragma unroll
                    for (int ks = 0; ks < 2; ++ks) aw[t] = __builtin_amdgcn_mfma_f32_16x16x32_bf16(*(const bf16x8*)(wt + ks * 32), xf[ks], aw[t], 0, 0, 0);
#pragma unroll
                    for (int ks = 0; ks < 2; ++ks) aa[t] = __builtin_amdgcn_mfma_f32_16x16x32_bf16(*(const bf16x8*)(wt + 64 + ks * 32), xf[2 + ks], aa[t], 0, 0, 0);
#pragma unroll
                    for (int ks = 0; ks < 5; ++ks) ag[t] = __builtin_amdgcn_mfma_f32_16x16x32_bf16(*(const bf16x8*)(wt + 128 + ks * 32), xf[4 + ks], ag[t], 0, 0, 0);
                    if (t == 1) asm volatile("" ::: "memory"); }
                if (args.sub & 32) {
#pragma unroll
                    for (int t = 0; t < 4; ++t) asm volatile("" :: "v"(aw[t]), "v"(aa[t]), "v"(ag[t]));
                    continue; }
                f32x4 kk4[4], av4[4], r4[4], dec4[4], k24[4]; float ssq = 0.f, bon = 0.f;
#pragma unroll
                for (int t = 0; t < 4; ++t) { const int c = head * 64 + 16 * t + 4 * fq;
                    const f32x4 zr = *(const f32x4*)(zrow + c), zk = *(const f32x4*)(zrow + 1024 + c);
                    f32x4 pr = (f32x4){0.f, 0.f, 0.f, 0.f}, pk = pr;
                    if (pz) { pr = *(const f32x4*)(pz + c); pk = *(const f32x4*)(pz + 1024 + c); }
                    const f32x4 r = zr + *(const f32x4*)(mu + c) * (pr - zr), k = zk + *(const f32x4*)(mu + 1024 + c) * (pk - zk);
                    const f32x4 w0v = *(const f32x4*)(w0 + c), a0v = *(const f32x4*)(a0 + c), kkv = *(const f32x4*)(k_k + c), kav = *(const f32x4*)(k_a + c), rkv = *(const f32x4*)(r_k + c);
                    r4[t] = r;
                    if (t == 2) {
#pragma unroll
                        for (int t2 = 0; t2 < 2; ++t2) { const size_t o2 = (size_t)row * 1024 + head * 64 + 16 * t2 + 4 * fq;
                            *(f32x4*)(aW + o2) = dec4[t2]; *(f32x4*)(aG + o2) = ag[t2]; } }
#pragma unroll
                    for (int q = 0; q < 4; ++q) { const float xx = -(w0v[q] + aw[t][q]);
                        const float sp = fmaxf(xx, 0.f) + __logf(1.0f + fexp(-fabsf(xx))); dec4[t][q] = fexp(-fexp(-sp - 0.5f));
                        av4[t][q] = fsig(a0v[q] + aa[t][q]); kk4[t][q] = k[q] * kkv[q]; k24[t][q] = k[q] * (1.0f + (av4[t][q] - 1.0f) * kav[q]);
                        ssq += kk4[t][q] * kk4[t][q]; bon += r[q] * k24[t][q] * rkv[q]; }
                    if (t == 1) asm volatile("" ::: "memory"); }
                ssq += __shfl_xor(ssq, 16); ssq += __shfl_xor(ssq, 32); bon += __shfl_xor(bon, 16); bon += __shfl_xor(bon, 32);
                const float inv = 1.0f / fmaxf(sqrtf(ssq), 1e-12f);
#pragma unroll
                for (int t = 0; t < 4; ++t) { const size_t o = (size_t)row * 1024 + head * 64 + 16 * t + 4 * fq;
                    const f32x4 kk = kk4[t] * inv, na = -kk, nb = kk * av4[t];
                    v4u X_, Y_; X_.x = pk2(r4[t].x, k24[t].x); X_.y = pk2(na.x, nb.x); X_.z = pk2(r4[t].y, k24[t].y); X_.w = pk2(na.y, nb.y);
                    Y_.x = pk2(r4[t].z, k24[t].z); Y_.y = pk2(na.z, nb.z); Y_.z = pk2(r4[t].w, k24[t].w); Y_.w = pk2(na.w, nb.w);
                    *(v4u*)(RKAB + o * 4) = X_; *(v4u*)(RKAB + o * 4 + 8) = Y_;
                    if (t >= 2) { *(f32x4*)(aW + o) = dec4[t]; *(f32x4*)(aG + o) = ag[t]; } }
                if (fq == 0) BON[(size_t)row * 16 + head] = bon;
            }
            __syncthreads();
        }
        { const int ngrp = MR / 16, rounds = (ngrp + G - 1) / G, nheavy = ngrp - (rounds - 1) * G;
          const int nlightb = G - nheavy;
          if (nlightb > 0 && (int)blockIdx.x >= nheavy) {
            LAS float* scr = (LAS float*)(L + wave * 16384);
            constexpr int I_G = 32 * 176, I_D = 88 * 64;
            for (int it = ((int)blockIdx.x - nheavy) * 8 + wave; it < 2 * I_G + I_D; it += nlightb * 8) {
                if (it < I_G) transpose_item(w_gate, 2048, DFF, WT_GU, 2, scr, it, lane);
                else if (it < 2 * I_G) transpose_item(w_up, 2048, DFF, WT_GU, 3, scr, it - I_G, lane);
                else transpose_item(w_down, DFF, 2048, WT_DN, 0, scr, it - 2 * I_G, lane);
            } } }
    }
    SEAM(2);
    if (IN(3)) {
        const int GH = G >> 1;
        if ((int)blockIdx.x >= GH) {
            const int bx = blockIdx.x - GH, GR = G - GH;
            if (args.sub & 2)
            for (int u = bx; u < 128; u += GR) ret_prompt_unit(L, ZB, ORET, out + OUT_RTP, u, tid);
            if (args.sub & 4)
            for (int u = bx; u < 512; u += GR) ret_sample_unit(L, ZB, state_ret, out + OUT_RTS, OAB, u, tid);
            if (args.sub & 16) sample_scan_units(ws, state_rwkv, state_shift, mu, out, SS_SPLIT + bx * 8 + wave, NS * 16 * 16, GR * 8, lane);
        } else {
        LAS float* buf = (LAS float*)L;
        LAS float* vbuf = buf + 2 * 16 * 320;
        const int ri = lane >> 4, cq = lane & 15;
        if (args.sub & 8)
        for (int u = blockIdx.x; u < 128; u += GH) {
            const int b = u >> 5, h = (u >> 1) & 15, hf = u & 1;
            const int rowb = b * TP;
            f32x4 S = (f32x4){0.f, 0.f, 0.f, 0.f};
            const int irow = hf * 32 + wave * 4 + ri;
            f32x4 prew[2]; v4u prex[2], prey[2]; float prevz[2], prevp[2];
            const bool l_last = tid < 256;
            const int l_st = (tid >> 4) & 15, l_c4 = tid & 15, l_off = l_st * 1024 + h * 64 + l_c4 * 4, l_lds = l_st * 320 + l_c4 * 4;
            const int v_st = tid >> 5, v_rr = tid & 31, v_col = 2048 + h * 64 + hf * 32 + v_rr;
            const float v_mu = mu[v_col];
            float keep = 0.f;
#define SCAN_LOAD(c, s_) do { const size_t rb_ = (size_t)(rowb + (c) * 16); \
            if (l_last) { prew[s_] = *(const f32x4*)(aW + rb_ * 1024 + l_off); prex[s_] = *(const v4u*)(RKAB + (rb_ * 1024 + l_off) * 4); prey[s_] = *(const v4u*)(RKAB + (rb_ * 1024 + l_off) * 4 + 8); } \
            { const int p_ = (c) * 16 + v_st; prevz[s_] = ZA[(size_t)(rowb + p_) * RC + v_col]; prevp[s_] = p_ == 0 ? 0.f : ZA[(size_t)(rowb + p_ - 1) * RC + v_col]; } } while (0)
#define SCAN_STORE(bb, s_) do { \
            if (l_last) { f32x4 r_, k_, a_, b_; rkab_unpack(prex[s_], prey[s_], r_, k_, a_, b_); LAS float* d_ = buf + (bb) * 5120 + l_lds; \
                *(LAS f32x4*)d_ = r_; *(LAS f32x4*)(d_ + 64) = prew[s_]; *(LAS f32x4*)(d_ + 128) = k_; *(LAS f32x4*)(d_ + 192) = a_; *(LAS f32x4*)(d_ + 256) = b_; } \
            vbuf[(bb) * 512 + v_st * 32 + v_rr] = prevz[s_] + v_mu * (prevp[s_] - prevz[s_]); } while (0)
#define SCAN_ITER(k) do { const int c = c0 + (k); if (c < 129) { \
                { const LAS float* bb = buf + ((k) & 1) * 5120; const LAS float* vb = vbuf + ((k) & 1) * 512; \
                    _Pragma("unroll 4") for (int st = 0; st < 16; ++st) { \
                        const f32x4 r4 = *(const LAS f32x4*)(bb + st * 320 + 0 * 64 + cq * 4), w4 = *(const LAS f32x4*)(bb + st * 320 + 1 * 64 + cq * 4), k4 = *(const LAS f32x4*)(bb + st * 320 + 2 * 64 + cq * 4); \
                        const f32x4 a4 = *(const LAS f32x4*)(bb + st * 320 + 3 * 64 + cq * 4), b4 = *(const LAS f32x4*)(bb + st * 320 + 4 * 64 + cq * 4); \
                        const float vi = vb[st * 32 + wave * 4 + ri]; \
                        float ov; SCAN_STEP(S, r4, w4, k4, a4, b4, vi, ov); \
                        keep = cq == st ? ov : keep; \
                    } } \
                if (c + 1 < 129) SCAN_STORE(((k) + 1) & 1, ((k) + 1) & 1); \
                if (c + 3 < 129) SCAN_LOAD(c + 3, ((k) + 1) & 1); \
                aO[(size_t)(rowb + c * 16 + cq) * 1024 + h * 64 + irow] = keep; \
                __syncthreads(); } } while (0)
            SCAN_LOAD(0, 0); SCAN_LOAD(1, 1); SCAN_STORE(0, 0); SCAN_LOAD(2, 0);
            __syncthreads();
            for (int c0 = 0; c0 < 129; c0 += 2) { SCAN_ITER(0); SCAN_ITER(1); }
            *(f32x4*)(out + OUT_RWP + ((size_t)((b * 16 + h) * 64 + irow)) * 64 + cq * 4) = S;
            __syncthreads();
        }
#undef SCAN_LOAD
#undef SCAN_STORE
#undef SCAN_ITER
        if (args.sub & 16) sample_scan_units(ws, state_rwkv, state_shift, mu, out, gw, SS_SPLIT, GH * 8, lane);
        }
    }
    SEAM(3);
    if (IN(4)) {
        for (int wu = gw; wu < MR * 4; wu += NGW) {
            const int row = wu >> 2, c = (wu & 3) * 256 + 4 * lane, head = c >> 6;
            const f32x4 o = *(const f32x4*)(aO + (size_t)row * 1024 + c);
            const float* zr = ZA + (size_t)row * RC + 2048 + c; const f32x4 z = *(const f32x4*)zr; f32x4 zp = (f32x4){0.f, 0.f, 0.f, 0.f};
            if (row < MP) { if ((row % TP) != 0) zp = *(const f32x4*)(zr - RC); }
            else { const int rr = row - MP; zp = (rr & 3) == 0 ? *(const f32x4*)(state_shift + (size_t)(rr >> 2) * RC + 2048 + c) : *(const f32x4*)(zr - RC); }
            const f32x4 muv = *(const f32x4*)(mu + 2048 + c), lw = *(const f32x4*)(ln_w + c), lb = *(const f32x4*)(ln_b + c), g = *(const f32x4*)(aG + (size_t)row * 1024 + c);
            const float bon = BON[(size_t)row * 16 + head];
            const float mean = rowsum16((o.x + o.y) + (o.z + o.w)) * (1.0f / 64.0f);
            const f32x4 d = o - mean;
            const float var = rowsum16((d.x * d.x + d.y * d.y) + (d.z * d.z + d.w * d.w)) * (1.0f / 64.0f);
            const float rs = 1.0f / sqrtf(var + 64e-5f);
            const f32x4 v = z + muv * (zp - z);
            const f32x4 res = (d * rs * lw + lb + v * bon) * g;
            v2u w; w.x = pk2(res.x, res.y); w.y = pk2(res.z, res.w);
            *(v2u*)(OAB + (size_t)row * 2048 + c) = w;
        }
        for (int wu = gw; wu < MP * 4; wu += NGW) {
            const int row = wu >> 2, h = wu & 3, c = h * 256 + 4 * lane;
            const f32x4 o = *(const f32x4*)(ORET + (size_t)row * 1024 + c);
            const float ss = wave_sum((o.x * o.x + o.y * o.y) + (o.z * o.z + o.w * o.w));
            const float rs = 1.0f / sqrtf(ss * (1.0f / 256.0f) + 1e-6f);
            const v2u gb = *(const v2u*)(ZB + (size_t)row * 4096 + 3072 + c);
            const float g0 = bf2f(gb.x & 0xffffu), g1 = bf2f(gb.x >> 16), g2_ = bf2f(gb.y & 0xffffu), g3 = bf2f(gb.y >> 16);
            v2u w; w.x = pk2(o.x * rs * (g0 / (1.0f + expf(-g0))), o.y * rs * (g1 / (1.0f + expf(-g1)))); w.y = pk2(o.z * rs * (g2_ / (1.0f + expf(-g2_))), o.w * rs * (g3 / (1.0f + expf(-g3))));
            *(v2u*)(OAB + (size_t)row * 2048 + 1024 + c) = w;
        }
        for (int i = gt; i < (NB + NS) * RC; i += NGT) { const int sq = i / RC, col = i - sq * RC;
            if (sq < NB) out[OUT_SHP + (size_t)sq * RC + col] = ZA[(size_t)(sq * TP + TP - 1) * RC + col];
            else out[OUT_SHS + (size_t)(sq - NB) * RC + col] = ZA[(size_t)(MP + 4 * (sq - NB) + 3) * RC + col]; }
    }
    SEAM(4);
    if (IN(5)) {
        pg8::Gemm g{OAB, WT_OUT, MPAD, DM, DM, DM};
        pg8::EpiOut E{H, x_prompt, x_sample, meta};
        GEMM_SPLIT(pg8::EpiOut, g, DM, E, 8, 256);
    }
    SEAM(5);
    if (IN(6)) {
        for (int m = gw; m < MPAD; m += 2 * NGW) { const int m1 = m + NGW;
            if (m1 < MR) rms_rows2_bf16(H + (size_t)m * DM, H + (size_t)m1 * DM, norm_ffn, XN + (size_t)m * DM, XN + (size_t)m1 * DM, lane);
            else { if (m < MR) rms_row_bf16(H + (size_t)m * DM, norm_ffn, XN + (size_t)m * DM, lane); else zero_row_bf16(XN + (size_t)m * DM, lane);
                   if (m1 < MPAD) zero_row_bf16(XN + (size_t)m1 * DM, lane); }
        }
    }
    SEAM(6);
    if (IN(7)) {
        pg8::Gemm g{XN, WT_GU, MPAD, 2 * DFF, DM, DM};
        pg8::EpiGateUp E{ACT};
        GEMM_SPLIT(pg8::EpiGateUp, g, 2 * DFF, E, 8, 256);
    }
    SEAM(7);
    if (IN(8)) {
        pg8::Gemm g{ACT, WT_DN, MPAD, DM, DFF, DFF};
        pg8::EpiDown E{H};
        GEMM_SPLIT(pg8::EpiDown, g, DM, E, 4, 1408);
    }
    SEAM(8);
    if (IN(9)) {
        for (int m = gw; m < MR; m += NGW) {
            float* dst;
            if (m < MP) { const int b = m / TP, p = m - b * TP; if (p < 16) continue; dst = out + OUT_YP + ((size_t)b * SEQ + (p - 16)) * DM; }
            else dst = out + OUT_YS + (size_t)(m - MP) * DM;
            const float* xr = H + (size_t)m * DM;
            f32x4 v[8]; float s = 0.f;
#pragma unroll
            for (int j = 0; j < 8; ++j) { v[j] = *(const f32x4*)(xr + 4 * lane + 256 * j); s += (v[j].x * v[j].x + v[j].y * v[j].y) + (v[j].z * v[j].z + v[j].w * v[j].w); }
            const float rs = 1.0f / sqrtf(wave_sum(s) * (1.0f / 2048.0f) + 1e-6f);
#pragma unroll
            for (int j = 0; j < 8; ++j) { const f32x4 g = *(const f32x4*)(norm_final + 4 * lane + 256 * j); *(f32x4*)(dst + 4 * lane + 256 * j) = v[j] * rs * g; }
        }
    }
#undef IN
#undef SEAM
#undef gw
#undef NGW
#undef gt
#undef NGT
}

#undef x_prompt
#undef x_sample
#undef state_shift
#undef state_rwkv
#undef state_ret
#undef meta
#undef norm_mix
#undef w_in
#undef mu
#undef w0
#undef w2
#undef a0
#undef a2
#undef g2
#undef k_k
#undef k_a
#undef r_k
#undef ln_w
#undef ln_b
#undef w_out
#undef norm_ffn
#undef w_gate
#undef w_up
#undef w_down
#undef norm_final
#undef out
#undef CS
#undef BON
#undef WT_IN
#undef WT_OUT
#undef WT_GU
#undef WT_DN
#undef XN
#undef OAB
#undef ZA
#undef ZB
#undef RKAB
#undef aW
#undef aG
#undef aO
#undef ORET
#undef H
#undef ACT
#undef IN_
#ifndef MK_MULTI
#define MK_MULTI 0
#endif
extern "C" void kernel_launch(void* const* d_in, const int* in_sizes, int n_in, void* d_out, int out_size, void* d_ws, size_t ws_size, hipStream_t stream) {
    static int grid = 0;
    if (grid == 0) {
        int dev = 0, cus = 0, per_cu = 0;
        (void)hipGetDevice(&dev);
        (void)hipDeviceGetAttribute(&cus, hipDeviceAttributeMultiprocessorCount, dev);
        (void)hipFuncSetAttribute((const void*)fwd, hipFuncAttributeMaxDynamicSharedMemorySize, LDS_BYTES);
        if (hipOccupancyMaxActiveBlocksPerMultiprocessor(&per_cu, (const void*)fwd, 512, LDS_BYTES) != hipSuccess || per_cu < 1) per_cu = 1;
        (void)hipGetLastError();
        if (per_cu > 1) per_cu = 1;
        grid = cus > 0 ? cus * per_cu : 256;
        if (ws_size < WS_END) fprintf(stderr, "kernel_launch: workspace too small: %zu < %zu\n", ws_size, (size_t)WS_END);
    }
    (void)hipMemsetAsync(d_ws, 0, 65536, stream);
    Args a{};
    for (int i = 0; i < 25; ++i) a.in[i] = (const float*)d_in[i];
    a.out = (float*)d_out; a.ws = (unsigned char*)d_ws; a.sub = 31;
#if MK_MULTI
#ifndef REPEAT_MASK
#define REPEAT_MASK 0
#endif
#ifndef REPEAT_SUB
#define REPEAT_SUB 7
#endif
    for (int ph = 0; ph < NPH; ++ph) for (int rep = 0; rep < 1 + ((REPEAT_MASK >> ph) & 1); ++rep) { a.ph_lo = ph; a.ph_hi = ph + 1; a.sub = rep ? REPEAT_SUB : 31; (void)hipMemsetAsync(d_ws, 0, 65536, stream); hipLaunchKernelGGL(fwd, dim3(grid), dim3(512), LDS_BYTES, stream, a); }
#else
    a.ph_lo = 0; a.ph_hi = NPH;
    void* kargs[] = {&a};
    hipError_t e = hipLaunchCooperativeKernel((const void*)fwd, dim3(grid), dim3(512), kargs, LDS_BYTES, stream);
    if (e != hipSuccess) fprintf(stderr, "cooperative launch failed: %s (grid %d)\n", hipGetErrorString(e), grid);
#endif
}
```
